# Optimizing an MI355X kernel written in HIP

```python
import math
import numpy as np
import jax
import jax.numpy as jnp
from jax import lax

D_MODEL = 2048
BATCH = 2
SEQ = 16384
DEPTH = 2

N_MIXERS = 2
GM_WIDTH = D_MODEL
GM_GROUPS = 8
GM_GROUP_DIM = GM_WIDTH // GM_GROUPS
GM_CHUNK = 128
NSA_HEAD_DIM = 128
NSA_HEADS = D_MODEL // NSA_HEAD_DIM
NSA_KV_HEADS = 4
NSA_GQA = NSA_HEADS // NSA_KV_HEADS
CMP_LEN = 32
CMP_STRIDE = 16
SEL_BLK = 64
SEL_TOPN = 16
SEL_LOCAL = 2
WINDOW = 512
Q_BLK = 128
FORCE = 1.0e4
NSA_Q_DIM = NSA_HEADS * NSA_HEAD_DIM
NSA_KV_DIM = NSA_KV_HEADS * NSA_HEAD_DIM
NSA_IN_DIM = NSA_Q_DIM + 6 * NSA_KV_DIM + 3 * NSA_HEADS
N_GROUPS = 4
EXP_PER_GROUP = 8
N_EXPERTS = N_GROUPS * EXP_PER_GROUP
TOP_K = 2
D_EXPERT = 512
MOE_BLK = 256
EPS = 1e-6
NEG = -1e30

kernel_name = "hybrid_gmlp_nsa_hmoe"


def rmsnorm(x, g):
    xf = x.astype(jnp.float32)
    y = xf * lax.rsqrt(jnp.mean(xf * xf, axis=-1, keepdims=True) + EPS)
    return (y * g.astype(jnp.float32)).astype(x.dtype)


def layernorm(x, g, b):
    xf = x.astype(jnp.float32)
    mu = jnp.mean(xf, axis=-1, keepdims=True)
    xc = xf - mu
    y = xc * lax.rsqrt(jnp.mean(xc * xc, axis=-1, keepdims=True) + EPS)
    return (y * g.astype(jnp.float32) + b.astype(jnp.float32)).astype(x.dtype)


def masked_softmax(s, mask):
    s = jnp.where(mask, s.astype(jnp.float32), NEG)
    m = jnp.max(s, axis=-1, keepdims=True)
    p = jnp.where(mask, jnp.exp(s - m), 0.0)
    return p / jnp.maximum(jnp.sum(p, axis=-1, keepdims=True), 1e-30)


def chunked_gmlp(h, w_in, ln_g, ln_b, w_s, b_s, w_out):
    B, S, _ = h.shape
    z = jax.nn.gelu(h @ w_in)
    u, v = jnp.split(z, 2, axis=-1)
    v = layernorm(v, ln_g, ln_b)
    v = v.reshape(B, S // GM_CHUNK, GM_CHUNK, GM_GROUPS, GM_GROUP_DIM)
    causal = jnp.tril(jnp.ones((GM_CHUNK, GM_CHUNK), dtype=w_s.dtype))
    sv = jnp.einsum('gts,bcsgd->bctgd', w_s * causal, v) + b_s.T[None, None, :, :, None]
    y = u * sv.reshape(B, S, GM_WIDTH)
    return y @ w_out


def compress_kv(k, pe, w1, w2):
    B, S, Hk, Dh = k.shape
    n_c = (S - CMP_LEN) // CMP_STRIDE + 1
    idx = np.arange(n_c)[:, None] * CMP_STRIDE + np.arange(CMP_LEN)[None, :]
    blocks = k[:, idx] + pe[None, None, :, None, :]
    flat = blocks.transpose(0, 1, 3, 2, 4).reshape(B, n_c, Hk, CMP_LEN * Dh)
    return jax.nn.gelu(flat @ w1) @ w2


def nsa_attention(h, w_in, ck_pe, ck_w1, ck_w2, cv_pe, cv_w1, cv_w2, w_out):
    B, S, _ = h.shape
    Hk, G, Dh = NSA_KV_HEADS, NSA_GQA, NSA_HEAD_DIM
    proj = h @ w_in
    splits = [NSA_Q_DIM + i * NSA_KV_DIM for i in range(7)]
    q, k_c, v_c, k_s, v_s, k_w, v_w, g = jnp.split(proj, splits, axis=-1)
    q = q.reshape(B, S, Hk, G, Dh) * (Dh ** -0.5)
    kv = lambda a: a.reshape(B, S, Hk, Dh)
    gates = jax.nn.sigmoid(g.astype(jnp.float32)).reshape(B, S, Hk, G, 3).astype(h.dtype)

    kc = compress_kv(kv(k_c), ck_pe, ck_w1, ck_w2)
    vc = compress_kv(kv(v_c), cv_pe, cv_w1, cv_w2)
    n_c = kc.shape[1]
    cmp_end = jnp.asarray(np.arange(n_c) * CMP_STRIDE + CMP_LEN - 1)
    n_sel = S // SEL_BLK
    n_top = min(SEL_TOPN, n_sel)
    ci = np.arange(n_c)[:, None] * CMP_STRIDE
    sj = np.arange(n_sel)[None, :] * SEL_BLK
    overlap = jnp.asarray(((ci < sj + SEL_BLK) & (ci + CMP_LEN > sj)).astype(np.float32))

    ks_blk = kv(k_s).reshape(B, n_sel, SEL_BLK, Hk, Dh).transpose(0, 3, 1, 2, 4)
    vs_blk = kv(v_s).reshape(B, n_sel, SEL_BLK, Hk, Dh).transpose(0, 3, 1, 2, 4)
    kw_pad = jnp.pad(kv(k_w), ((0, 0), (WINDOW, 0), (0, 0), (0, 0)))
    vw_pad = jnp.pad(kv(v_w), ((0, 0), (WINDOW, 0), (0, 0), (0, 0)))
    gather = jax.vmap(jax.vmap(lambda blocks, idx: blocks[idx]))
    blk = jnp.arange(n_sel)

    def query_block(qb):
        q0 = qb * Q_BLK
        t = q0 + jnp.arange(Q_BLK)
        qblk = lax.dynamic_slice_in_dim(q, q0, Q_BLK, axis=1)
        gblk = lax.dynamic_slice_in_dim(gates, q0, Q_BLK, axis=1)
        mask_c = cmp_end[None, :] <= t[:, None]
        p_c = masked_softmax(jnp.einsum('bqhgd,bchd->bhgqc', qblk, kc), mask_c)
        o_c = jnp.einsum('bhgqc,bchd->bqhgd', p_c.astype(vc.dtype), vc)
        imp = jnp.einsum('bhgqc,cj->bhqj', p_c, overlap)
        cur = (t // SEL_BLK)[:, None]
        valid = blk[None, :] * SEL_BLK <= t[:, None]
        dist = cur - blk[None, :]
        forced = (blk[None, :] == 0) | ((dist >= 0) & (dist < SEL_LOCAL))
        score = jnp.where(valid, jnp.where(forced, FORCE, imp), NEG)
        _, top_idx = lax.top_k(score, n_top)
        k_sel = gather(ks_blk, top_idx).reshape(B, Hk, Q_BLK, n_top * SEL_BLK, Dh)
        v_sel = gather(vs_blk, top_idx).reshape(B, Hk, Q_BLK, n_top * SEL_BLK, Dh)
        pos_s = (top_idx[..., None] * SEL_BLK + jnp.arange(SEL_BLK)).reshape(B, Hk, Q_BLK, n_top * SEL_BLK)
        mask_s = (pos_s <= t[:, None])[:, :, None]
        p_s = masked_softmax(jnp.einsum('bqhgd,bhqkd->bhgqk', qblk, k_sel), mask_s)
        o_s = jnp.einsum('bhgqk,bhqkd->bqhgd', p_s.astype(v_sel.dtype), v_sel)
        k_win = lax.dynamic_slice_in_dim(kw_pad, q0, WINDOW + Q_BLK, axis=1)
        v_win = lax.dynamic_slice_in_dim(vw_pad, q0, WINDOW + Q_BLK, axis=1)
        pos_w = q0 - WINDOW + jnp.arange(WINDOW + Q_BLK)
        mask_w = (pos_w[None, :] <= t[:, None]) & (pos_w[None, :] > t[:, None] - WINDOW) & (pos_w[None, :] >= 0)
        p_w = masked_softmax(jnp.einsum('bqhgd,bkhd->bhgqk', qblk, k_win), mask_w)
        o_w = jnp.einsum('bhgqk,bkhd->bqhgd', p_w.astype(v_win.dtype), v_win)
        o = gblk[..., 0:1] * o_c + gblk[..., 1:2] * o_s + gblk[..., 2:3] * o_w
        return o.reshape(B, Q_BLK, NSA_Q_DIM)

    o = lax.map(query_block, jnp.arange(S // Q_BLK))
    o = o.transpose(1, 0, 2, 3).reshape(B, S, NSA_Q_DIM)
    return o @ w_out


def hier_moe(h, w_group, b_group, w_exp, b_exp, w_gate, w_up, w_down):
    B, S, D = h.shape
    T = B * S
    xt = h.reshape(T, D)
    g_prob = jax.nn.softmax((xt @ w_group).astype(jnp.float32) + b_group.astype(jnp.float32), axis=-1)
    g_w, g_idx = lax.top_k(g_prob, 1)
    e_logits = ((xt @ w_exp).astype(jnp.float32) + b_exp.astype(jnp.float32)).reshape(T, N_GROUPS, EXP_PER_GROUP)
    e_logits = jnp.take_along_axis(e_logits, g_idx[:, :, None], axis=1)[:, 0]
    e_w, e_idx = lax.top_k(jax.nn.softmax(e_logits, axis=-1), TOP_K)
    e_w = e_w / jnp.sum(e_w, axis=-1, keepdims=True)
    weight = (g_w * e_w).reshape(-1)
    expert = (g_idx * EXP_PER_GROUP + e_idx).reshape(-1).astype(jnp.int32)
    token = jnp.repeat(jnp.arange(T, dtype=jnp.int32), TOP_K)
    n_assign = T * TOP_K
    order = jnp.argsort(expert)
    s_exp, s_tok, s_w = expert[order], token[order], weight[order]
    counts = jnp.bincount(expert, length=N_EXPERTS)
    padded = (counts + MOE_BLK - 1) // MOE_BLK * MOE_BLK
    pad_end = jnp.cumsum(padded)
    pad_start = pad_end - padded
    start = jnp.cumsum(counts) - counts
    dest = pad_start[s_exp] + jnp.arange(n_assign, dtype=jnp.int32) - start[s_exp]
    n_rows = (n_assign + MOE_BLK - 1) // MOE_BLK * MOE_BLK + N_EXPERTS * MOE_BLK
    n_blocks = n_rows // MOE_BLK
    row_tok = jnp.full((n_rows,), T, jnp.int32).at[dest].set(s_tok)
    row_w = jnp.zeros((n_rows,), jnp.float32).at[dest].set(s_w)
    block_exp = jnp.minimum(jnp.searchsorted(pad_end, jnp.arange(n_blocks) * MOE_BLK, side='right'),
                            N_EXPERTS - 1)
    x_pad = jnp.concatenate([xt, jnp.zeros((1, D), xt.dtype)], axis=0)

    def run_block(args):
        rows, e = args
        xb = x_pad[rows]
        return (jax.nn.silu(xb @ w_gate[e]) * (xb @ w_up[e])) @ w_down[e]

    y = lax.map(run_block, (row_tok.reshape(n_blocks, MOE_BLK), block_exp))
    y = y.reshape(n_rows, D) * row_w[:, None].astype(y.dtype)
    out = jnp.zeros((T + 1, D), y.dtype).at[row_tok].add(y)[:T]
    return out.reshape(B, S, D)


def setup_inputs(seed: int = 0) -> dict:
    key = jax.random.key(seed)
    keys = list(jax.random.split(key, 32))

    def nrm(shape, scale):
        return jax.random.normal(keys.pop(), shape, jnp.float32) * scale

    n_a = (DEPTH + N_MIXERS - 1) // N_MIXERS
    n_b = DEPTH // N_MIXERS
    Dh = NSA_HEAD_DIM
    return {
        "x": nrm((BATCH, SEQ, D_MODEL), 1.0),
        "norm_mix": 1.0 + nrm((DEPTH, D_MODEL), 0.02),
        "norm_ffn": 1.0 + nrm((DEPTH, D_MODEL), 0.02),
        "norm_final": 1.0 + nrm((D_MODEL,), 0.02),
        "a_w_in": nrm((n_a, D_MODEL, 2 * GM_WIDTH), D_MODEL ** -0.5),
        "a_ln_g": 1.0 + nrm((n_a, GM_WIDTH), 0.02),
        "a_ln_b": nrm((n_a, GM_WIDTH), 0.02),
        "a_w_s": nrm((n_a, GM_GROUPS, GM_CHUNK, GM_CHUNK), GM_CHUNK ** -0.5),
        "a_b_s": 1.0 + nrm((n_a, GM_GROUPS, GM_CHUNK), 0.02),
        "a_w_out": nrm((n_a, GM_WIDTH, D_MODEL), GM_WIDTH ** -0.5),
        "b_w_in": nrm((n_b, D_MODEL, NSA_IN_DIM), D_MODEL ** -0.5),
        "b_ck_pe": nrm((n_b, CMP_LEN, Dh), 0.1),
        "b_ck_w1": nrm((n_b, CMP_LEN * Dh, Dh), (CMP_LEN * Dh) ** -0.5),
        "b_ck_w2": nrm((n_b, Dh, Dh), Dh ** -0.5),
        "b_cv_pe": nrm((n_b, CMP_LEN, Dh), 0.1),
        "b_cv_w1": nrm((n_b, CMP_LEN * Dh, Dh), (CMP_LEN * Dh) ** -0.5),
        "b_cv_w2": nrm((n_b, Dh, Dh), Dh ** -0.5),
        "b_w_out": nrm((n_b, NSA_Q_DIM, D_MODEL), NSA_Q_DIM ** -0.5),
        "r_w_group": nrm((DEPTH, D_MODEL, N_GROUPS), D_MODEL ** -0.5),
        "r_b_group": nrm((DEPTH, N_GROUPS), 0.01),
        "r_w_exp": nrm((DEPTH, D_MODEL, N_EXPERTS), D_MODEL ** -0.5),
        "r_b_exp": nrm((DEPTH, N_EXPERTS), 0.01),
        "e_w_gate": nrm((DEPTH, N_EXPERTS, D_MODEL, D_EXPERT), D_MODEL ** -0.5),
        "e_w_up": nrm((DEPTH, N_EXPERTS, D_MODEL, D_EXPERT), D_MODEL ** -0.5),
        "e_w_down": nrm((DEPTH, N_EXPERTS, D_EXPERT, D_MODEL), D_EXPERT ** -0.5),
    }


def reference(x, norm_mix, norm_ffn, norm_final, a_w_in, a_ln_g, a_ln_b, a_w_s, a_b_s, a_w_out,
              b_w_in, b_ck_pe, b_ck_w1, b_ck_w2, b_cv_pe, b_cv_w1, b_cv_w2, b_w_out,
              r_w_group, r_b_group, r_w_exp, r_b_exp, e_w_gate, e_w_up, e_w_down):
    h = x
    for i in range(DEPTH):
        hn = rmsnorm(h, norm_mix[i])
        j = i // N_MIXERS
        if i % N_MIXERS == 0:
            mix = chunked_gmlp(hn, a_w_in[j], a_ln_g[j], a_ln_b[j], a_w_s[j], a_b_s[j], a_w_out[j])
        else:
            mix = nsa_attention(hn, b_w_in[j], b_ck_pe[j], b_ck_w1[j], b_ck_w2[j],
                                b_cv_pe[j], b_cv_w1[j], b_cv_w2[j], b_w_out[j])
        h = h + mix
        h = h + hier_moe(rmsnorm(h, norm_ffn[i]), r_w_group[i], r_b_group[i], r_w_exp[i], r_b_exp[i],
                         e_w_gate[i], e_w_up[i], e_w_down[i])
    return rmsnorm(h, norm_final)
```

```cpp
#include <hip/hip_runtime.h>
#include <cstdio>
#include <cstdint>

#define GAS __attribute__((address_space(1)))
#define LAS __attribute__((address_space(3)))
typedef unsigned short bf16;
typedef short bf16x8 __attribute__((ext_vector_type(8)));
typedef short s16x4 __attribute__((ext_vector_type(4)));
typedef float f32x4 __attribute__((ext_vector_type(4)));
typedef float f32x2 __attribute__((ext_vector_type(2)));
typedef unsigned u32x4 __attribute__((ext_vector_type(4)));
typedef unsigned u32x2 __attribute__((ext_vector_type(2)));

constexpr int DM = 2048, NB = 2, SEQ = 16384, T = NB * SEQ;
constexpr int GMW = 2048, GMG = 8, GMGD = 256, GMC = 128;
constexpr int HD = 128, NH = 16, NKV = 4, GQ = 4;
constexpr int CMPL = 32, CMPS = 16, SELB = 64, TOPN = 16, WIN = 512;
constexpr int NCMP = 1023, NSEL = 256;
constexpr int NSA_IN = 5168, NSA_INP = 5376;
constexpr int NGRP = 4, EPG = 8, NEXP = 32, DEXP = 512;
constexpr float EPSN = 1e-6f;
constexpr int LCAP = 32768;
constexpr int HIDROWS = 2 * T + NEXP * 256;

constexpr size_t MiB = 1u << 20;
constexpr size_t WS_CTL = 0, CTL_ZERO_BYTES = 2 * MiB;
constexpr size_t CT_BAR = 1 * MiB;
constexpr size_t CT_CNT = 128 * 1024;
constexpr size_t CT_SSQ1 = 256 * 1024;
constexpr size_t CT_SSQ3 = 384 * 1024;
constexpr size_t CT_LNS = 512 * 1024;
constexpr size_t WS_SMALL = 2 * MiB;
constexpr size_t SM_SSQ0 = WS_SMALL;
constexpr size_t SM_SSQ2 = SM_SSQ0 + 128 * 1024;
constexpr size_t SM_LTOK = SM_SSQ2 + 128 * 1024;
constexpr size_t SM_LW = SM_LTOK + 4 * MiB;
constexpr size_t SM_LRS = SM_LW + 4 * MiB;
constexpr size_t SM_GATES = SM_LRS + 4 * MiB;
constexpr size_t SM_CBIAS = SM_GATES + 6 * MiB;
constexpr size_t SM_SELM = SM_CBIAS + 64 * 1024;
constexpr size_t SM_END = SM_SELM + 4 * MiB;
static_assert(SM_END <= 32 * MiB, "small region");
constexpr size_t WS_WMISC = 32 * MiB;
constexpr size_t WM_AIN = WS_WMISC;
constexpr size_t WM_AOUT = WM_AIN + 16 * MiB;
constexpr size_t WM_BIN = WM_AOUT + 8 * MiB;
constexpr size_t WM_BOUT = WM_BIN + 21 * MiB;
constexpr size_t WM_C1 = WM_BOUT + 8 * MiB;
constexpr size_t WM_WR = WM_C1 + 2 * MiB;
constexpr size_t WM_WS = WM_WR + 2 * MiB;
constexpr size_t WM_SSQP = WM_WS + 1 * MiB;
constexpr size_t WM_END = WM_SSQP + 4 * MiB;
constexpr size_t WS_WGU = 96 * MiB;
constexpr size_t WS_WD = WS_WGU + 128 * MiB;
constexpr size_t WS_HB = WS_WD + 64 * MiB;
constexpr size_t WS_SCR = WS_HB + 128 * MiB;
static_assert(WM_END <= WS_WGU, "wmisc");
constexpr size_t SC_U = WS_SCR, SC_V = SC_U + 128 * MiB, SC_LNSP = SC_V + 128 * MiB;
constexpr size_t SC_HID = WS_SCR, SC_Y = SC_HID + 72 * MiB;
constexpr size_t SC_Q = WS_SCR;
constexpr size_t SC_KV = SC_Q + 128 * MiB;
constexpr size_t SC_OW = SC_KV + 192 * MiB;
constexpr size_t SC_OC = SC_OW + 128 * MiB;
constexpr size_t SC_LOHI = SC_OC + 128 * MiB;
constexpr size_t SC_KC = SC_LOHI + 16 * MiB;
constexpr size_t WS_END = SC_KC + 4 * MiB;
static_assert(SC_Y + 256 * MiB <= WS_END && WS_END <= 1100 * MiB, "ws map");

#define RLX_AGENT __ATOMIC_RELAXED, __HIP_MEMORY_SCOPE_AGENT
#define LDS_WAIT() asm volatile("s_waitcnt lgkmcnt(0)" ::: "memory")
#define VM_WAIT() asm volatile("s_waitcnt vmcnt(0)" ::: "memory")
#define SBAR() __builtin_amdgcn_sched_barrier(0)
__device__ __forceinline__ unsigned f2bf(float f) { unsigned u = __builtin_bit_cast(unsigned, f); return (u + 0x7fffu + ((u >> 16) & 1u)) >> 16; }
__device__ __forceinline__ unsigned pk2(float lo, float hi) { unsigned r; asm volatile("v_cvt_pk_bf16_f32 %0, %1, %2" : "=v"(r) : "v"(lo), "v"(hi)); return r; }
__device__ __forceinline__ float bf_lo(unsigned w) { return __builtin_bit_cast(float, w << 16); }
__device__ __forceinline__ float bf_hi(unsigned w) { return __builtin_bit_cast(float, w & 0xffff0000u); }
__device__ __forceinline__ float wave_sum(float v) {
#pragma unroll
    for (int o = 1; o < 64; o <<= 1) v += __shfl_xor(v, o);
    return v;
}
__device__ __forceinline__ f32x2 gelu_pk(f32x2 v) {
    const f32x2 av = __builtin_elementwise_abs(v), d = av * 0.2316418882f + 1.0f;
    f32x2 t; t.x = __builtin_amdgcn_rcpf(d.x); t.y = __builtin_amdgcn_rcpf(d.y);
    f32x2 q = t * 0.5307027145f + (-0.7265760135f); q = q * t + 0.7107068705f; q = q * t + (-0.142248368f); q = q * t + 0.127414796f; q = q * t;
    const f32x2 s = (v * v) * (-0.72134752044f);
    f32x2 e; e.x = __builtin_amdgcn_exp2f(s.x); e.y = __builtin_amdgcn_exp2f(s.y);
    const f32x2 m = v * (q * e), r = v - m;
    f32x2 o; o.x = v.x < 0.f ? m.x : r.x; o.y = v.y < 0.f ? m.y : r.y; return o;
}
__device__ __forceinline__ float gelu1(float x) { f32x2 r = gelu_pk((f32x2){x, 0.f}); return r.x; }
__device__ __forceinline__ int lane_id_fresh() { int l; asm volatile("v_mbcnt_lo_u32_b32 %0, -1, 0\n\tv_mbcnt_hi_u32_b32 %0, -1, %0" : "=v"(l)); return l; }
__device__ __forceinline__ float rstd_of(float ssq) { return __builtin_amdgcn_rsqf(ssq * (1.0f / DM) + EPSN); }

#define XB_TMO      128
#define XB_XCNT(j)  (256  + 64 * (j))
#define XB_XSUB(j)  (1280 + 64 * (j))
#define XB_XGEN(j)  (2304 + 64 * (j))
#define XB_TOP      3328
#define XB_TOPGEN   3392
#define XCD_BAR_WORDS 3456
#define XB_SPIN_CAP (1u << 20)
__device__ __forceinline__ unsigned xb_ld(unsigned* p)              { return __hip_atomic_load(p, __ATOMIC_RELAXED, __HIP_MEMORY_SCOPE_AGENT); }
__device__ __forceinline__ unsigned xb_add(unsigned* p, unsigned v) { return __hip_atomic_fetch_add(p, v, __ATOMIC_RELAXED, __HIP_MEMORY_SCOPE_AGENT); }
__device__ __forceinline__ unsigned xb_xcc_id() { return (unsigned)__builtin_amdgcn_s_getreg((3 << 11) | 20) & 0xFu; }
#define XB_SPIN(cond, bar) do { unsigned _sp = 0; while (cond) { __builtin_amdgcn_s_sleep(1); \
    if ((++_sp & 255u) == 0u) { if (xb_ld(&(bar)[XB_TMO])) break; if (_sp > XB_SPIN_CAP) { atomicAdd(&(bar)[XB_TMO], 1u); break; } } } } while (0)
struct XcdBarrier { unsigned* bar; unsigned x; volatile LAS unsigned* st; };
__device__ __forceinline__ XcdBarrier xcd_barrier_post(unsigned* bar, volatile LAS unsigned* st, int tid) {
    XcdBarrier b; b.bar = bar; b.x = xb_xcc_id(); b.st = st;
    if (tid == 0) (void)xb_add(&bar[XB_XCNT(b.x)], 1u);
    return b;
}
__device__ __forceinline__ void xcd_barrier_complete(unsigned* bar, unsigned x, unsigned& nloc, unsigned& nx) {
    const unsigned G = gridDim.x * gridDim.y * gridDim.z;
    unsigned sum, cnt, mine, sp = 0u;
    for (;;) {
        sum = 0u; cnt = 0u; mine = 0u;
#pragma unroll
        for (unsigned j = 0; j < 16; ++j) { const unsigned c = xb_ld(&bar[XB_XCNT(j)]); sum += c; cnt += (c > 0u) ? 1u : 0u; mine = (j == x) ? c : mine; }
        if (sum == G) break;
        __builtin_amdgcn_s_sleep(1);
        if ((++sp & 255u) == 0u) { if (xb_ld(&bar[XB_TMO])) break; if (sp > XB_SPIN_CAP) { atomicAdd(&bar[XB_TMO], 1u); break; } }
    }
    nloc = mine > 0u ? mine : 1u; nx = cnt > 0u ? cnt : 1u;
}
__device__ __forceinline__ void xcd_barrier(const XcdBarrier& b, int tid) {
    asm volatile("s_waitcnt vmcnt(0)" ::: "memory");
    __syncthreads();
    if (tid == 0) {
        unsigned* bar = b.bar;
        __builtin_amdgcn_s_waitcnt(0);
        unsigned nloc = b.st[0], nx = b.st[1];
        if (nloc == 0u) { xcd_barrier_complete(bar, b.x, nloc, nx); b.st[0] = nloc; b.st[1] = nx; }
        const unsigned old = xb_add(&bar[XB_XSUB(b.x)], 1u);
        const unsigned gen = old / nloc;
        if (old + 1u == (gen + 1u) * nloc) {
            __builtin_amdgcn_fence(__ATOMIC_RELEASE, "agent");
            asm volatile("s_waitcnt vmcnt(0)" ::: "memory");
            const unsigned og = xb_add(&bar[XB_TOP], 1u);
            const unsigned tg = og / nx;
            if (og + 1u == (tg + 1u) * nx) xb_add(&bar[XB_TOPGEN], 1u);
            else XB_SPIN(xb_ld(&bar[XB_TOPGEN]) == tg, bar);
            __builtin_amdgcn_fence(__ATOMIC_ACQUIRE, "agent");
            xb_add(&bar[XB_XGEN(b.x)], 1u);
            asm volatile("s_waitcnt vmcnt(0)" ::: "memory");
        } else {
            XB_SPIN(xb_ld(&bar[XB_XGEN(b.x)]) == gen, bar);
            __builtin_amdgcn_fence(__ATOMIC_ACQUIRE, "agent");
            asm volatile("s_waitcnt vmcnt(0)" ::: "memory");
        }
    }
    __syncthreads();
}

namespace pg8 {
constexpr int BM = 256, BK = 64, HALF = 128, HTB = HALF * BK * 2, STAGE_BYTES = 8 * HTB;
__host__ __device__ __forceinline__ int lds_byte(int r, int c) { const int st = (r >> 4) * 2 + (c >> 5), rr = r & 15, cc = c & 31, ob = rr * 64 + cc * 2; return st * 1024 + (ob ^ (((ob >> 9) & 1) << 5)); }
__host__ __device__ __forceinline__ void stage_rc(int b, int& R, int& C) { const int st = b / 1024, sb = b % 1024, swz = sb ^ (((sb >> 9) & 1) << 5); R = (st >> 1) * 16 + swz / 64; C = (st & 1) * 32 + (swz % 64) / 2; }
__host__ __device__ __forceinline__ int perm32(int rho) { const int n = rho >> 4, i = rho & 15; return 8 * (i >> 2) + 4 * n + (i & 3); }
struct Unit { int pm, pn, e, aux; };
template <class Epi, class P>
__device__ __forceinline__ void gemm_phase(LAS unsigned char* lds, const P& S, const Epi& E, const int tid) {
    const int wid = __builtin_amdgcn_readfirstlane(tid >> 6), lane = tid & 63, wr = wid >> 2, wc = wid & 3, fr = lane & 15, fq = lane >> 4;
    const int nt = S.nt;
    unsigned voffB[2];
#pragma unroll
    for (int i = 0; i < 2; ++i) { int R, C; stage_rc(tid * 16 + i * 8192, R, C); const int Rb = Epi::PERM ? ((R & ~31) + perm32(R & 31)) : R;
        voffB[i] = (unsigned)(Rb * S.ldb + C) * 2u; }
    const size_t hstepB = (size_t)HALF * S.ldb * 2;
    const unsigned ldsw = (unsigned)wid * 1024u;
    const int aoff = lds_byte(wr * 64 + fr, fq * 8), boff = lds_byte(wc * 32 + fr, fq * 8);
#define PG8_SA(b, h) (((b) * 2 + (h)) * HTB)
#define PG8_SB(b, h) ((4 + (b) * 2 + (h)) * HTB)
#define PG8_STAGE(bufoff, gbase, voff) do { _Pragma("unroll") for (int _i = 0; _i < 2; ++_i) \
        __builtin_amdgcn_global_load_lds((const unsigned*)((const char*)(gbase) + (voff)[_i]), (LAS unsigned*)(lds + (bufoff) + ldsw + _i * 8192), 16, 0, 0); } while (0)
#define PG8_LDA(dst, b, h) do { _Pragma("unroll") for (int m = 0; m < 4; ++m) _Pragma("unroll") for (int k = 0; k < 2; ++k) dst[m][k] = *(const LAS bf16x8*)(lds + PG8_SA(b, h) + aoff + m * 2048 + k * 1024); } while (0)
#define PG8_LDB(dst, b, h) do { _Pragma("unroll") for (int n = 0; n < 2; ++n) _Pragma("unroll") for (int k = 0; k < 2; ++k) dst[n][k] = *(const LAS bf16x8*)(lds + PG8_SB(b, h) + boff + n * 2048 + k * 1024); } while (0)
#define PG8_MMA(ai, bj, At, Bt) do { __builtin_amdgcn_s_setprio(1); _Pragma("unroll") for (int m = 0; m < 4; ++m) _Pragma("unroll") for (int n = 0; n < 2; ++n) _Pragma("unroll") for (int k = 0; k < 2; ++k) \
        acc[ai][bj][m][n] = __builtin_amdgcn_mfma_f32_16x16x32_bf16(Bt[n][k], At[m][k], acc[ai][bj][m][n], 0, 0, 0); __builtin_amdgcn_s_setprio(0); } while (0)
#define PG8_WAIT_V(n) asm volatile("s_waitcnt vmcnt(" #n ")" ::: "memory")
#define PG8_WAIT_L(n) asm volatile("s_waitcnt lgkmcnt(" #n ")" ::: "memory")
#define PG8_BAR __builtin_amdgcn_s_barrier()
#define PG8_SCHED __builtin_amdgcn_sched_barrier(0)
#define PG8_AOFF(dst, u) do { _Pragma("unroll") for (int _i = 0; _i < 2; ++_i) { int _R, _C; stage_rc(tid * 16 + _i * 8192, _R, _C); \
        _Pragma("unroll") for (int _h = 0; _h < 2; ++_h) dst[_h][_i] = S.a_row(u, _h * HALF + _R) + (unsigned)(_C * 2); } } while (0)
    Unit cur, nxt; int ui = 0;
    if (!S.next(0, cur)) return;
    f32x4 acc[2][2][4][2];
#pragma unroll
    for (int a = 0; a < 2; ++a)
#pragma unroll
        for (int b = 0; b < 2; ++b)
#pragma unroll
            for (int m = 0; m < 4; ++m)
#pragma unroll
                for (int n = 0; n < 2; ++n) acc[a][b][m][n] = (f32x4){0.f, 0.f, 0.f, 0.f};
    bf16x8 At[4][2], B0[2][2], B1[2][2];
    unsigned cAo[2][2], nAo[2][2];
    PG8_AOFF(cAo, cur);
    const char* cB = S.B + S.b_base(cur);
    const char* const Ab = S.A;
    {
        const char* a0 = Ab + S.a_k(0); const char* a1 = Ab + S.a_k(1);
        PG8_STAGE(PG8_SB(0, 0), cB, voffB); PG8_STAGE(PG8_SB(0, 1), cB + hstepB, voffB); PG8_STAGE(PG8_SA(0, 0), a0, cAo[0]); PG8_STAGE(PG8_SA(0, 1), a0, cAo[1]);
        if (wr == 1) PG8_BAR;
        PG8_WAIT_V(2); PG8_BAR;
        PG8_STAGE(PG8_SB(1, 0), cB + 128, voffB); PG8_STAGE(PG8_SA(1, 0), a1, cAo[0]); PG8_STAGE(PG8_SB(1, 1), cB + hstepB + 128, voffB);
        PG8_WAIT_V(6); PG8_BAR;
    }
    for (;;) {
        const bool has_next = S.next(ui + 1, nxt);
        const char* nB = cB;
        if (has_next) { PG8_AOFF(nAo, nxt); nB = S.B + S.b_base(nxt); }
        else {
#pragma unroll
            for (int _h = 0; _h < 2; ++_h)
#pragma unroll
                for (int _i = 0; _i < 2; ++_i) nAo[_h][_i] = cAo[_h][_i];
        }
        for (int t = 0; t < nt; t += 2) {
            const bool last = (t == nt - 2);
            const char* a1 = Ab + S.a_k(t + 1);
            const char* a2 = Ab + (last ? S.a_k(0) : S.a_k(t + 2)); const char* b2 = last ? nB : cB + (size_t)(t + 2) * 128;
            const char* a3 = Ab + (last ? S.a_k(1) : S.a_k(t + 3)); const char* b3 = b2 + 128;
            PG8_LDB(B0, 0, 0); PG8_LDB(B1, 0, 1); PG8_SCHED; PG8_LDA(At, 0, 0); PG8_STAGE(PG8_SA(1, 1), a1, cAo[1]);
            PG8_WAIT_V(8); PG8_WAIT_L(0); PG8_BAR; PG8_MMA(0, 0, At, B0); PG8_MMA(0, 1, At, B1); PG8_BAR; PG8_SCHED;
            PG8_LDA(At, 0, 1); PG8_STAGE(PG8_SB(0, 0), b2, voffB); PG8_STAGE(PG8_SB(0, 1), b2 + hstepB, voffB);
            if (last) { PG8_STAGE(PG8_SA(0, 0), a2, nAo[0]); } else { PG8_STAGE(PG8_SA(0, 0), a2, cAo[0]); }
            PG8_WAIT_V(8); PG8_WAIT_L(0); PG8_BAR; PG8_MMA(1, 0, At, B0); PG8_MMA(1, 1, At, B1); PG8_BAR; PG8_SCHED;
            PG8_LDB(B0, 1, 0); PG8_LDB(B1, 1, 1); PG8_SCHED; PG8_LDA(At, 1, 0);
            if (last) { PG8_STAGE(PG8_SA(0, 1), a2, nAo[1]); } else { PG8_STAGE(PG8_SA(0, 1), a2, cAo[1]); }
            PG8_WAIT_V(8); PG8_WAIT_L(0); PG8_BAR; PG8_MMA(0, 0, At, B0); PG8_MMA(0, 1, At, B1); PG8_BAR; PG8_SCHED;
            PG8_LDA(At, 1, 1); PG8_STAGE(PG8_SB(1, 0), b3, voffB); PG8_STAGE(PG8_SB(1, 1), b3 + hstepB, voffB);
            if (last) { PG8_STAGE(PG8_SA(1, 0), a3, nAo[0]); } else { PG8_STAGE(PG8_SA(1, 0), a3, cAo[0]); }
            PG8_WAIT_V(8); PG8_WAIT_L(0); PG8_BAR; PG8_MMA(1, 0, At, B0); PG8_MMA(1, 1, At, B1); PG8_BAR; PG8_SCHED;
        }
        if (wr == 0) PG8_BAR;
        if constexpr (!Epi::AFTER_DRAIN) { E(acc, cur, wr, wc, fr, fq); }
        if (!has_next) break;
#pragma unroll
        for (int a = 0; a < 2; ++a)
#pragma unroll
            for (int b = 0; b < 2; ++b)
#pragma unroll
                for (int m = 0; m < 4; ++m)
#pragma unroll
                    for (int n = 0; n < 2; ++n) acc[a][b][m][n] = (f32x4){0.f, 0.f, 0.f, 0.f};
        cur = nxt; cB = nB; ++ui;
#pragma unroll
        for (int _h = 0; _h < 2; ++_h)
#pragma unroll
            for (int _i = 0; _i < 2; ++_i) cAo[_h][_i] = nAo[_h][_i];
        if (wr == 1) PG8_BAR;
    }
    PG8_WAIT_V(0);
    PG8_BAR;
    if constexpr (Epi::AFTER_DRAIN) { E.fused(acc, cur, wr, wc, fr, fq, lds, wid, lane, tid); }
#undef PG8_SA
#undef PG8_SB
#undef PG8_STAGE
#undef PG8_LDA
#undef PG8_LDB
#undef PG8_MMA
#undef PG8_WAIT_V
#undef PG8_WAIT_L
#undef PG8_BAR
#undef PG8_SCHED
#undef PG8_AOFF
}
}

constexpr int NWAVES = 8, NTHR = 512;
constexpr int RING_OFF = 0, RING_BYTES = 131072;
constexpr int LDS_BYTES = 147456;
constexpr int LCTL_OFF = LDS_BYTES - 1024;
constexpr int LDS_DUMMY = 0;
constexpr int LW_BAR = 0;
constexpr int LW_BLKPRE = 8;
constexpr int LW_CNT = 48;
constexpr int LW_HIST = 96;
constexpr int LW_BASE = 128;

struct Args { unsigned char* ws; float* out; int ph_lo, ph_hi, li, pad; unsigned long long padq[4]; const float* in[25]; };
struct Frame {
    LAS unsigned char* lds;
    volatile LAS unsigned* LW;
    unsigned char* ws;
    int tid, lane, wave, vcu, G;
    const Args* ap;
    float* out;
};
#define CAS __attribute__((address_space(4)))
__device__ __forceinline__ const float* kin(int i) { return ((const float* const CAS*)((const CAS char*)__builtin_amdgcn_kernarg_segment_ptr() + __builtin_offsetof(Args, in)))[i]; }
#define FIN(i) kin(i)
enum { I_X = 0, I_NMIX, I_NFFN, I_NFIN, I_AWIN, I_ALNG, I_ALNB, I_AWS, I_ABS, I_AWOUT, I_BWIN, I_CKPE, I_CKW1, I_CKW2, I_CVPE, I_CVW1, I_CVW2, I_BWOUT,
       I_RWG, I_RBG, I_RWE, I_RBE, I_EWG, I_EWU, I_EWD };

__device__ __forceinline__ void tr_item(const float* W, int ldw, int k0, int n0, int nvalid, const float* gain, float scale, bf16* D, int ldd, int dk0, int drow0, LAS float* scr, int lane) {
    const int nn = lane & 31;
#pragma unroll 8
    for (int i = 0; i < 32; ++i) { const int kk = 2 * i + (lane >> 5); float v = 0.f; if (nn < nvalid) v = W[(size_t)(k0 + kk) * ldw + n0 + nn];
        if (gain) v *= gain[k0 + kk]; scr[kk * 33 + nn] = v * scale; }
    LDS_WAIT(); asm volatile("" ::: "memory");
    const int c = lane & 7;
#pragma unroll
    for (int j = 0; j < 4; ++j) { const int n = (lane >> 3) + 8 * j; const LAS float* s = scr + (8 * c) * 33 + n;
        u32x4 o; o.x = pk2(s[0 * 33], s[1 * 33]); o.y = pk2(s[2 * 33], s[3 * 33]); o.z = pk2(s[4 * 33], s[5 * 33]); o.w = pk2(s[6 * 33], s[7 * 33]);
        if (n < nvalid) *(GAS u32x4*)(D + (size_t)(drow0 + n) * ldd + dk0 + k0 + 8 * c) = o; }
    LDS_WAIT(); asm volatile("" ::: "memory");
}
__device__ __forceinline__ void moe_weight_items(Frame& F, int layer, int gw, int NGW) {
    LAS float* scr = (LAS float*)(F.lds + RING_OFF + F.wave * 16384);
    bf16* WGU = (bf16*)(F.ws + WS_WGU); bf16* WD = (bf16*)(F.ws + WS_WD);
    const float* gain = FIN(I_NFFN) + layer * DM;
    constexpr int IG = 32 * 16, ID = 8 * 64;
    constexpr int PER_E = 2 * IG + ID;
    for (int it = gw; it < NEXP * PER_E; it += NGW) {
        const int e = it / PER_E; int r = it % PER_E;
        if (r < 2 * IG) { const int up = r >= IG; if (up) r -= IG; const int kb = r / 16, nb = r % 16, n0 = nb * 32;
            const float* W = FIN(up ? I_EWU : I_EWG) + ((size_t)(layer * NEXP + e) * DM) * DEXP;
            tr_item(W, DEXP, kb * 64, n0, 32, gain, 1.f, WGU + (size_t)e * 1024 * DM, DM, 0, (n0 >> 7) * 256 + up * 128 + (n0 & 127), scr, F.lane);
        } else { r -= 2 * IG; const int kb = r / 64, nb = r % 64;
            const float* W = FIN(I_EWD) + ((size_t)(layer * NEXP + e) * DEXP) * DM;
            tr_item(W, DM, kb * 64, nb * 32, 32, nullptr, 1.f, WD + (size_t)e * DM * DEXP, DEXP, 0, nb * 32, scr, F.lane); }
    }
}
__device__ __forceinline__ void p0_prologue(Frame& F) {
    LAS float* scr = (LAS float*)(F.lds + RING_OFF + F.wave * 16384);
    const int gw = F.vcu * NWAVES + F.wave, NGW = F.G * NWAVES;
    bf16* AIN = (bf16*)(F.ws + WM_AIN); bf16* AOUT = (bf16*)(F.ws + WM_AOUT); bf16* BIN = (bf16*)(F.ws + WM_BIN); bf16* BOUT = (bf16*)(F.ws + WM_BOUT);
    bf16* C1 = (bf16*)(F.ws + WM_C1); bf16* WR = (bf16*)(F.ws + WM_WR); bf16* WSB = (bf16*)(F.ws + WM_WS);
    constexpr int N_AIN = 32 * 128, N_AOUT = 32 * 64, N_BIN = 32 * 162, N_BOUT = 32 * 64, N_C1 = 2 * 2 * 32 * 4, N_WRE = 2 * 32;
    constexpr int NITEMS = N_AIN + N_AOUT + N_BIN + N_BOUT + N_C1 + N_WRE;
    constexpr float QS = 0.08838834764831845f * 1.4426950408889634f;
    for (int it = gw; it < NITEMS; it += NGW) {
        int r = it;
        if (r < N_AIN) { tr_item(FIN(I_AWIN), 2 * GMW, (r / 128) * 64, (r % 128) * 32, 32, FIN(I_NMIX), 1.f, AIN, DM, 0, (r % 128) * 32, scr, F.lane); continue; } r -= N_AIN;
        if (r < N_AOUT) { tr_item(FIN(I_AWOUT), DM, (r / 64) * 64, (r % 64) * 32, 32, nullptr, 1.f, AOUT, GMW, 0, (r % 64) * 32, scr, F.lane); continue; } r -= N_AOUT;
        if (r < N_BIN) { const int nb = r % 162, n0 = nb * 32; const int nv = (NSA_IN - n0) < 32 ? (NSA_IN - n0) : 32;
            tr_item(FIN(I_BWIN), NSA_IN, (r / 162) * 64, n0, nv, FIN(I_NMIX) + DM, n0 < 2048 ? QS : 1.f, BIN, DM, 0, n0, scr, F.lane); continue; } r -= N_BIN;
        if (r < N_BOUT) { tr_item(FIN(I_BWOUT), DM, (r / 64) * 64, (r % 64) * 32, 32, nullptr, 1.f, BOUT, DM, 0, (r % 64) * 32, scr, F.lane); continue; } r -= N_BOUT;
        if (r < N_C1) { const int which = r / 256, half = (r / 128) & 1, kb = (r / 4) & 31, nb = r & 3;
            tr_item(FIN(which ? I_CVW1 : I_CKW1) + (size_t)half * 2048 * HD, HD, kb * 64, nb * 32, 32, nullptr, 1.f, C1 + (size_t)which * 256 * 2048, 2048, 0, half * 128 + nb * 32, scr, F.lane); continue; } r -= N_C1;
        { const int layer = r / 32, kb = r % 32;
          tr_item(FIN(I_RWE) + (size_t)layer * DM * NEXP, NEXP, kb * 64, 0, 32, FIN(I_NFFN) + layer * DM, 1.f, WR + (size_t)layer * 256 * DM, DM, 0, 4, scr, F.lane); }
    }
    moe_weight_items(F, 0, gw, NGW);
    const int gt = (F.vcu * NTHR) + F.tid, NGT = F.G * NTHR;
    for (int i = gt; i < 2 * NGRP * DM; i += NGT) { const int layer = i / (NGRP * DM), j = (i / DM) % NGRP, k = i % DM;
        WR[(size_t)layer * 256 * DM + (size_t)j * DM + k] = (bf16)f2bf(FIN(I_RWG)[(size_t)layer * DM * NGRP + (size_t)k * NGRP + j] * FIN(I_NFFN)[layer * DM + k]); }
    for (int i = gt; i < GMG * GMC * GMC; i += NGT) { const int t = (i / GMC) % GMC, s = i % GMC; WSB[i] = (bf16)f2bf(s <= t ? FIN(I_AWS)[i] : 0.f); }
    for (int i = gw; i < 2 * HD; i += NGW) { const int which = i / HD, n = i % HD; const float* pe = FIN(which ? I_CVPE : I_CKPE); const float* w1 = FIN(which ? I_CVW1 : I_CKW1);
        float s = 0.f; for (int k = F.lane; k < CMPL * HD; k += 64) s += pe[k] * w1[(size_t)k * HD + n]; s = wave_sum(s); if (F.lane == 0) ((float*)(F.ws + SM_CBIAS))[i] = s; }
    float* ssq0 = (float*)(F.ws + SM_SSQ0); bf16* HB = (bf16*)(F.ws + WS_HB);
    for (int m = gw; m < T; m += NGW) {
        const GAS f32x4* xr = (const GAS f32x4*)(FIN(I_X) + (size_t)m * DM) + F.lane; f32x4 v[8]; float s = 0.f;
#pragma unroll
        for (int j = 0; j < 8; ++j) { v[j] = xr[64 * j]; s += (v[j].x * v[j].x + v[j].y * v[j].y) + (v[j].z * v[j].z + v[j].w * v[j].w); }
        s = wave_sum(s); if (F.lane == 0) ssq0[m] = s;
        GAS u32x2* o8 = (GAS u32x2*)(HB + (size_t)m * DM) + F.lane;
#pragma unroll
        for (int j = 0; j < 8; ++j) { u32x2 w; w.x = pk2(v[j].x, v[j].y); w.y = pk2(v[j].z, v[j].w); o8[64 * j] = w; }
    }
}

template <bool FINAL, bool ADDY = true>
__device__ __forceinline__ void combine_phase(Frame& F, float* ssq_out) {
    const int gw = F.vcu * NWAVES + F.wave, NGW = F.G * NWAVES;
    bf16* HB = (bf16*)(F.ws + WS_HB); const bf16* Y0 = (const bf16*)(F.ws + SC_Y); const bf16* Y1 = Y0 + (size_t)T * DM;
    for (int m = gw; m < T; m += NGW) {
        const GAS u32x4* h4 = (const GAS u32x4*)(HB + (size_t)m * DM) + F.lane; const GAS u32x4* a4 = (const GAS u32x4*)(Y0 + (size_t)m * DM) + F.lane; const GAS u32x4* b4 = (const GAS u32x4*)(Y1 + (size_t)m * DM) + F.lane;
        float v[4][8]; float s = 0.f;
#pragma unroll
        for (int j = 0; j < 4; ++j) { const u32x4 h = h4[64 * j], a = a4[64 * j], b = b4[64 * j];
#pragma unroll
            for (int q = 0; q < 4; ++q) { v[j][2 * q] = bf_lo(h[q]) + (ADDY ? bf_lo(a[q]) + bf_lo(b[q]) : 0.f); v[j][2 * q + 1] = bf_hi(h[q]) + (ADDY ? bf_hi(a[q]) + bf_hi(b[q]) : 0.f); } }
        if constexpr (!FINAL) {
#pragma unroll
            for (int j = 0; j < 4; ++j) { u32x4 w;
#pragma unroll
                for (int q = 0; q < 4; ++q) { w[q] = pk2(v[j][2 * q], v[j][2 * q + 1]); const float lo = bf_lo(w[q]), hi = bf_hi(w[q]); s += lo * lo + hi * hi; }
                ((GAS u32x4*)(HB + (size_t)m * DM) + F.lane)[64 * j] = w; }
            s = wave_sum(s); if (F.lane == 0) ssq_out[m] = s;
        } else {
#pragma unroll
            for (int j = 0; j < 4; ++j)
#pragma unroll
                for (int q = 0; q < 8; ++q) s += v[j][q] * v[j][q];
            s = wave_sum(s); const float rs = rstd_of(s);
            const float* g = FIN(I_NFIN);
#pragma unroll
            for (int j = 0; j < 4; ++j) { const int c0 = 8 * F.lane + 512 * j; const f32x4 g0 = *(const f32x4*)(g + c0), g1 = *(const f32x4*)(g + c0 + 4);
                f32x4 o0 = {v[j][0] * rs * g0.x, v[j][1] * rs * g0.y, v[j][2] * rs * g0.z, v[j][3] * rs * g0.w}, o1 = {v[j][4] * rs * g1.x, v[j][5] * rs * g1.y, v[j][6] * rs * g1.z, v[j][7] * rs * g1.w};
                *(GAS f32x4*)(F.out + (size_t)m * DM + c0) = o0; *(GAS f32x4*)(F.out + (size_t)m * DM + c0 + 4) = o1; }
        }
    }
}

using pg8::Unit;
struct DenseP {
    const char* A; const char* B; int nt, ldb; unsigned lda_b;
    int nM, nN, nwg, G, c;
    __device__ __forceinline__ void init(const void* A_, unsigned lda_bytes, const void* B_, int ldb_, int K, int M, int N, int G_, int c_) {
        A = (const char*)A_; B = (const char*)B_; lda_b = lda_bytes; ldb = ldb_; nt = K / 64; nM = M / 256; nN = N / 256; nwg = nM * nN; G = G_; c = c_; }
    __device__ __forceinline__ bool next(int i, Unit& u) const {
        const long L = (long)i * G + c; if (L >= nwg) return false;
        int wgid = (int)L; { const int q = nwg / 8, r = nwg % 8, xcd = wgid % 8, off = wgid / 8; wgid = (xcd < r ? xcd * (q + 1) : r * (q + 1) + (xcd - r) * q) + off; }
        const int nig = 8 * nN, gid = wgid / nig, fm = gid * 8, gsz = (nM - fm) < 8 ? (nM - fm) : 8;
        u.pm = fm + ((wgid % nig) % gsz); u.pn = (wgid % nig) / gsz; u.e = 0; u.aux = 0; return true;
    }
    __device__ __forceinline__ unsigned a_row(const Unit& u, int r) const { return (unsigned)(u.pm * 256 + r) * lda_b; }
    __device__ __forceinline__ size_t a_k(int kt) const { return (size_t)kt * 128; }
    __device__ __forceinline__ size_t b_base(const Unit& u) const { return (size_t)u.pn * 256 * ldb * 2; }
};
struct HeadMajorP : DenseP {
    __device__ __forceinline__ unsigned a_row(const Unit& u, int r) const { const int row = u.pm * 256 + r; const int b = row / SEQ, t = row % SEQ; return (unsigned)((b * NH * SEQ + t) * (HD * 2)); }
    __device__ __forceinline__ size_t a_k(int kt) const { return (size_t)(kt >> 1) * ((size_t)SEQ * HD * 2) + (size_t)(kt & 1) * 128; }
};
constexpr size_t KVS = 32 * MiB;
struct CmpP : DenseP {
    __device__ __forceinline__ bool next(int i, Unit& u) const { const int L = i * G + c; if (L >= 64) return false; u.pm = L & 31; u.pn = 0; u.e = L >> 5; u.aux = 0; return true; }
    __device__ __forceinline__ unsigned a_row(const Unit& u, int r) const { return (unsigned)(u.e * KVS) + (unsigned)(u.pm * 256 + r) * 4096u; }
    __device__ __forceinline__ size_t b_base(const Unit& u) const { return (size_t)u.e * 256 * 2048 * 2; }
};
struct MoeP {
    const char* A; const char* B; int nt, ldb;
    int NP, G, c, total; const volatile LAS unsigned* blkpre; const volatile LAS unsigned* cnt; const int* ltok; bool gather;
    __device__ __forceinline__ bool next(int i, Unit& u) const {
        const int L = i * G + c; if (L >= total) return false;
        const int blk = L / NP; u.pn = L % NP; int e = 0;
_Pragma("unroll 1")
        for (int s = 16; s >= 1; s >>= 1) { if ((unsigned)__builtin_amdgcn_readfirstlane((int)blkpre[e + s]) <= (unsigned)blk) e += s; }
        const int mb = blk - __builtin_amdgcn_readfirstlane((int)blkpre[e]); int valid = __builtin_amdgcn_readfirstlane((int)cnt[e]) - mb * 256; valid = valid > 256 ? 256 : valid;
        u.pm = blk; u.e = e; u.aux = valid | (mb << 16); return true;
    }
    __device__ __forceinline__ unsigned a_row(const Unit& u, int r) const {
        if (gather) { const int valid = u.aux & 0xffff, mb = u.aux >> 16; const int rr = r < valid ? r : valid - 1; return (unsigned)(ltok[u.e * LCAP + mb * 256 + rr] >> 1) * (unsigned)(DM * 2); }
        return (unsigned)(u.pm * 256 + r) * (unsigned)(DEXP * 2);
    }
    __device__ __forceinline__ size_t a_k(int kt) const { return (size_t)kt * 128; }
    __device__ __forceinline__ size_t b_base(const Unit& u) const { return gather ? ((size_t)u.e * 1024 + (size_t)u.pn * 256) * DM * 2 : ((size_t)u.e * DM + (size_t)u.pn * 256) * DEXP * 2; }
};

#define EPI_ROWS(...) _Pragma("unroll") for (int ai = 0; ai < 2; ++ai) _Pragma("unroll") for (int m = 0; m < 4; ++m) { const int rl = ai * 128 + wr * 64 + m * 16 + fr; __VA_ARGS__ }
__device__ __forceinline__ u32x4 pack8f(const f32x4 a, const f32x4 b) { u32x4 w; w.x = pk2(a[0], a[1]); w.y = pk2(a[2], a[3]); w.z = pk2(b[0], b[1]); w.w = pk2(b[2], b[3]); return w; }
__device__ __forceinline__ f32x4 gelu4(f32x4 v) { const f32x2 a = gelu_pk((f32x2){v[0], v[1]}), b = gelu_pk((f32x2){v[2], v[3]}); return (f32x4){a.x, a.y, b.x, b.y}; }

struct EpiA1 {
    static constexpr bool PERM = true, AFTER_DRAIN = false;
    const float* ssq; bf16* U; bf16* V; float* lns;
    __device__ __forceinline__ void operator()(const f32x4 (&acc)[2][2][4][2], const Unit& u, int wr, int wc, int fr, int fq) const {
        const bool isv = u.pn >= 8; bf16* dst = isv ? V : U; const int colt = (isv ? u.pn - 8 : u.pn) * 256 + wc * 32 + 8 * fq;
        EPI_ROWS({ const int row = u.pm * 256 + rl; const float rs = rstd_of(ssq[row]); float s1 = 0.f, s2 = 0.f;
_Pragma("unroll")
            for (int bj = 0; bj < 2; ++bj) { const f32x4 v0 = gelu4(acc[ai][bj][m][0] * rs), v1 = gelu4(acc[ai][bj][m][1] * rs);
                *(GAS u32x4*)(dst + (size_t)row * GMW + colt + bj * 128) = pack8f(v0, v1);
                s1 += (v0[0] + v0[1]) + (v0[2] + v0[3]) + (v1[0] + v1[1]) + (v1[2] + v1[3]);
                s2 += (v0[0] * v0[0] + v0[1] * v0[1]) + (v0[2] * v0[2] + v0[3] * v0[3]) + (v1[0] * v1[0] + v1[1] * v1[1]) + (v1[2] * v1[2] + v1[3] * v1[3]); }
            if (isv) { s1 += __shfl_xor(s1, 16); s1 += __shfl_xor(s1, 32); s2 += __shfl_xor(s2, 16); s2 += __shfl_xor(s2, 32);
                if (fq == 0) *(GAS f32x2*)(lns + ((size_t)row * 32 + (u.pn - 8) * 4 + wc) * 2) = (f32x2){s1, s2}; } })
    }
};
struct EpiRes {
    static constexpr bool PERM = true, AFTER_DRAIN = false;
    bf16* HB; float* ssq;
    __device__ __forceinline__ void operator()(const f32x4 (&acc)[2][2][4][2], const Unit& u, int wr, int wc, int fr, int fq) const {
        const int colt = u.pn * 256 + wc * 32 + 8 * fq;
        EPI_ROWS({ const int row = u.pm * 256 + rl; float s2 = 0.f;
_Pragma("unroll")
            for (int bj = 0; bj < 2; ++bj) { GAS u32x4* p = (GAS u32x4*)(HB + (size_t)row * DM + colt + bj * 128); const u32x4 h = *p; u32x4 w;
                const f32x4 a0 = acc[ai][bj][m][0], a1 = acc[ai][bj][m][1];
                w.x = pk2(bf_lo(h.x) + a0[0], bf_hi(h.x) + a0[1]); w.y = pk2(bf_lo(h.y) + a0[2], bf_hi(h.y) + a0[3]);
                w.z = pk2(bf_lo(h.z) + a1[0], bf_hi(h.z) + a1[1]); w.w = pk2(bf_lo(h.w) + a1[2], bf_hi(h.w) + a1[3]);
                *p = w;
_Pragma("unroll")
                for (int q = 0; q < 4; ++q) { const float lo = bf_lo(w[q]), hi = bf_hi(w[q]); s2 += lo * lo + hi * hi; } }
            s2 += __shfl_xor(s2, 16); s2 += __shfl_xor(s2, 32);
            if (fq == 0) ssq[(size_t)row * 32 + u.pn * 4 + wc] = s2; })
    }
};
struct EpiN1 {
    static constexpr bool PERM = true, AFTER_DRAIN = false;
    const float* ssq; bf16* Q; bf16* KV; float* gates;
    __device__ __forceinline__ void operator()(const f32x4 (&acc)[2][2][4][2], const Unit& u, int wr, int wc, int fr, int fq) const {
        const int cin = wc * 32 + 8 * fq;
        if (u.pn < 20) {
            EPI_ROWS({ const int row = u.pm * 256 + rl; const float rs = rstd_of(ssq[row]); const int b = row / SEQ, t = row % SEQ;
_Pragma("unroll")
                for (int bj = 0; bj < 2; ++bj) { bf16* dst;
                    if (u.pn < 8) dst = Q + ((size_t)(b * NH + u.pn * 2 + bj) * SEQ + t) * HD;
                    else { const int idx = (u.pn - 8) >> 1, head = ((u.pn - 8) & 1) * 2 + bj; dst = (bf16*)((char*)KV + (size_t)idx * KVS) + ((size_t)(b * NKV + head) * SEQ + t) * HD; }
                    *(GAS u32x4*)(dst + cin) = pack8f(acc[ai][0 + bj][m][0] * rs, acc[ai][0 + bj][m][1] * rs); } })
        } else {
            if (cin < 48) { EPI_ROWS({ const int row = u.pm * 256 + rl; const float rs = rstd_of(ssq[row]);
                f32x4 g0 = acc[ai][0][m][0] * rs, g1 = acc[ai][0][m][1] * rs;
_Pragma("unroll")
                for (int j = 0; j < 4; ++j) { g0[j] = __builtin_amdgcn_rcpf(1.f + __builtin_amdgcn_exp2f(-1.4426950408889634f * g0[j])); g1[j] = __builtin_amdgcn_rcpf(1.f + __builtin_amdgcn_exp2f(-1.4426950408889634f * g1[j])); }
                *(GAS f32x4*)(gates + (size_t)row * 48 + cin) = g0; *(GAS f32x4*)(gates + (size_t)row * 48 + cin + 4) = g1; }) }
        }
    }
};
struct EpiF32 {
    static constexpr bool PERM = false, AFTER_DRAIN = false;
    float* C;
    __device__ __forceinline__ void operator()(const f32x4 (&acc)[2][2][4][2], const Unit& u, int wr, int wc, int fr, int fq) const {
        EPI_ROWS({ float* rowp = C + ((size_t)u.e * 8192 + u.pm * 256 + rl) * 256 + wc * 32 + 4 * fq;
_Pragma("unroll")
            for (int bj = 0; bj < 2; ++bj)
_Pragma("unroll")
                for (int n = 0; n < 2; ++n) *(GAS f32x4*)(rowp + bj * 128 + n * 16) = acc[ai][bj][m][n]; })
    }
};
struct EpiM2 {
    static constexpr bool PERM = true, AFTER_DRAIN = false;
    const float* lrs; bf16* HID;
    __device__ __forceinline__ void operator()(const f32x4 (&acc)[2][2][4][2], const Unit& u, int wr, int wc, int fr, int fq) const {
        const int valid = u.aux & 0xffff, mb = u.aux >> 16, colt = u.pn * 128 + wc * 32 + 8 * fq;
        EPI_ROWS({ float rs = 0.f; if (rl < valid) rs = lrs[u.e * LCAP + mb * 256 + rl];
            f32x4 o[2];
_Pragma("unroll")
            for (int n = 0; n < 2; ++n) { const f32x4 g = acc[ai][0][m][n] * rs, up = acc[ai][1][m][n] * rs;
_Pragma("unroll")
                for (int j = 0; j < 4; ++j) o[n][j] = g[j] * __builtin_amdgcn_rcpf(1.f + __builtin_amdgcn_exp2f(-1.4426950408889634f * g[j])) * up[j]; }
            *(GAS u32x4*)(HID + ((size_t)u.pm * 256 + rl) * DEXP + colt) = pack8f(o[0], o[1]); asm volatile("" ::: "memory"); })
    }
};
struct EpiM3 {
    static constexpr bool PERM = true, AFTER_DRAIN = false;
    const int* ltok; const float* lw; bf16* Y;
    __device__ __forceinline__ void operator()(const f32x4 (&acc)[2][2][4][2], const Unit& u, int wr, int wc, int fr, int fq) const {
        const int valid = u.aux & 0xffff, mb = u.aux >> 16, colt = u.pn * 256 + wc * 32 + 8 * fq;
        EPI_ROWS({ if (rl < valid) { const int ent = ltok[u.e * LCAP + mb * 256 + rl]; const float w = lw[u.e * LCAP + mb * 256 + rl];
            bf16* dst = Y + ((size_t)(ent & 1) * T + (size_t)(ent >> 1)) * DM + colt;
_Pragma("unroll")
            for (int bj = 0; bj < 2; ++bj) *(GAS u32x4*)(dst + bj * 128) = pack8f(acc[ai][bj][m][0] * w, acc[ai][bj][m][1] * w); } })
    }
};
struct EpiRouter {
    static constexpr bool PERM = false, AFTER_DRAIN = true;
    const float* ssq; const float* bg; const float* be; unsigned* gcnt; int* ltok; float* lw; float* lrs; volatile LAS unsigned* LW;
    __device__ __forceinline__ void fused(f32x4 (&acc)[2][2][4][2], const Unit& u, int wr, int wc, int fr, int fq, LAS unsigned char* lds, int wid, int lane, const int tid) const {
        LAS float* LG = (LAS float*)lds;
        if (wc < 2) { EPI_ROWS({
_Pragma("unroll")
            for (int n = 0; n < 2; ++n) { const int col = wc * 32 + 16 * n + 4 * fq; if (col < 48) *(LAS f32x4*)(LG + rl * 48 + col) = acc[ai][0][m][n]; } }) }
        if (tid < 32) LW[LW_HIST + tid] = 0u;
        __syncthreads();
        int e0 = 0, e1 = 0, p0 = 0, p1 = 0; float w0 = 0.f, w1 = 0.f, rs = 0.f; const int row = u.pm * 256 + tid;
        if (tid < 256) {
            { float sq = 0.f; const GAS f32x4* sp = (const GAS f32x4*)(ssq + (size_t)row * 32);
              _Pragma("unroll") for (int j = 0; j < 8; ++j) { const f32x4 v = sp[j]; sq += (v[0] + v[1]) + (v[2] + v[3]); }
              rs = rstd_of(sq); }
            float gl[4]; int gi = 0;
_Pragma("unroll")
            for (int j = 0; j < 4; ++j) gl[j] = LG[tid * 48 + j] * rs + bg[j];
_Pragma("unroll")
            for (int j = 1; j < 4; ++j) if (gl[j] > gl[gi]) gi = j;
            float gs = 0.f;
_Pragma("unroll")
            for (int j = 0; j < 4; ++j) gs += __expf(gl[j] - gl[gi]);
            const float gwt = 1.f / gs;
            float el[8];
_Pragma("unroll")
            for (int j = 0; j < 8; ++j) el[j] = LG[tid * 48 + 4 + gi * 8 + j] * rs + be[gi * 8 + j];
            int i0 = 0;
_Pragma("unroll")
            for (int j = 1; j < 8; ++j) if (el[j] > el[i0]) i0 = j;
            int i1 = (i0 == 0) ? 1 : 0;
_Pragma("unroll")
            for (int j = 0; j < 8; ++j) if (j != i0 && el[j] > el[i1]) i1 = j;
            const float r = __expf(el[i1] - el[i0]); const float q0 = 1.f / (1.f + r), q1 = r * q0;
            w0 = gwt * q0; w1 = gwt * q1; e0 = gi * 8 + i0; e1 = gi * 8 + i1;
            p0 = (int)__hip_atomic_fetch_add((LAS unsigned*)&LW[LW_HIST + e0], 1u, __ATOMIC_RELAXED, __HIP_MEMORY_SCOPE_WORKGROUP);
            p1 = (int)__hip_atomic_fetch_add((LAS unsigned*)&LW[LW_HIST + e1], 1u, __ATOMIC_RELAXED, __HIP_MEMORY_SCOPE_WORKGROUP);
        }
        __syncthreads();
        if (tid < 32) { const unsigned h = LW[LW_HIST + tid]; LW[LW_BASE + tid] = h ? __hip_atomic_fetch_add(gcnt + 64 * tid, h, __ATOMIC_RELAXED, __HIP_MEMORY_SCOPE_AGENT) : 0u; }
        __syncthreads();
        if (tid < 256) {
            const int d0 = e0 * LCAP + (int)LW[LW_BASE + e0] + p0, d1 = e1 * LCAP + (int)LW[LW_BASE + e1] + p1;
            ltok[d0] = row * 2; lw[d0] = w0; lrs[d0] = rs; ltok[d1] = row * 2 + 1; lw[d1] = w1; lrs[d1] = rs;
        }
        __syncthreads();
    }
};

#define TRRD(dst, base, off) asm volatile("ds_read_b64_tr_b16 %0, %1 offset:%2" : "=&v"(dst) : "v"(base), "i"(off) : "memory")
__device__ __forceinline__ bf16x8 mk8(s16x4 a, s16x4 b) { return (bf16x8){a[0], a[1], a[2], a[3], b[0], b[1], b[2], b[3]}; }
__device__ __forceinline__ unsigned lds_addr(const LAS void* p) { return (unsigned)(size_t)p; }

__device__ __forceinline__ void gating_phase(Frame& F) {
    const bf16* V = (const bf16*)(F.ws + SC_V); bf16* U = (bf16*)(F.ws + SC_U);
    const float* lnsp = (const float*)(F.ws + SC_LNSP); const bf16* WSB = (const bf16*)(F.ws + WM_WS);
    LAS f32x2* lst = (LAS f32x2*)(F.lds + 128 * 544);
    const float* lng = FIN(I_ALNG); const float* lnb = FIN(I_ALNB); const float* bsp = FIN(I_ABS);
    constexpr int VSTG = 544;
    LAS unsigned char* vl = F.lds;
    const int lane = F.lane, c = lane & 15, kq = lane >> 4, q = c >> 2, p = c & 3;
    const unsigned vb = lds_addr(vl) + (unsigned)((4 * kq + q) * VSTG + 8 * p);
    for (int unit = F.vcu; unit < 2048; unit += F.G) {
        const int chunk = unit >> 3, g = unit & 7, row0 = chunk * GMC;
        if (F.tid < GMC) { const GAS f32x4* sp = (const GAS f32x4*)(lnsp + (size_t)(row0 + F.tid) * 64); float s1 = 0.f, s2 = 0.f;
#pragma unroll
            for (int j = 0; j < 16; ++j) { const f32x4 v = sp[j]; s1 += v[0] + v[2]; s2 += v[1] + v[3]; }
            const float mean = s1 * (1.f / GMW); float var = s2 * (1.f / GMW) - mean * mean; var = var > 0.f ? var : 0.f;
            lst[F.tid] = (f32x2){mean, __builtin_amdgcn_rsqf(var + EPSN)}; }
        __syncthreads();
#pragma unroll 2
        for (int i = 0; i < 8; ++i) { const int idx = F.tid + 512 * i, r = idx >> 5, ch = idx & 31;
            const u32x4 raw = *(const GAS u32x4*)(V + (size_t)(row0 + r) * GMW + g * GMGD + ch * 8);
            const f32x2 st = lst[r]; const float mean = st.x, rstd = st.y;
            const f32x4 g0 = *(const f32x4*)(lng + g * GMGD + ch * 8), g1 = *(const f32x4*)(lng + g * GMGD + ch * 8 + 4), b0 = *(const f32x4*)(lnb + g * GMGD + ch * 8), b1 = *(const f32x4*)(lnb + g * GMGD + ch * 8 + 4);
            f32x4 x0 = {bf_lo(raw.x), bf_hi(raw.x), bf_lo(raw.y), bf_hi(raw.y)}, x1 = {bf_lo(raw.z), bf_hi(raw.z), bf_lo(raw.w), bf_hi(raw.w)};
            x0 = (x0 - mean) * rstd * g0 + b0; x1 = (x1 - mean) * rstd * g1 + b1;
            *(LAS u32x4*)(vl + r * VSTG + ch * 16) = pack8f(x0, x1); }
        __syncthreads();
        const bf16* wrow = WSB + ((size_t)g * GMC + 16 * F.wave + c) * GMC + 4 * kq;
        bf16x8 wf[4];
#pragma unroll
        for (int sl = 0; sl < 4; ++sl) { const u32x2 lo = *(const GAS u32x2*)(wrow + 32 * sl), hi = *(const GAS u32x2*)(wrow + 32 * sl + 16); u32x4 w = {lo.x, lo.y, hi.x, hi.y}; wf[sl] = __builtin_bit_cast(bf16x8, w); }
        const int t = row0 + 16 * F.wave + c; const float bst = bsp[g * GMC + 16 * F.wave + c];
        bf16* urow = U + (size_t)t * GMW + g * GMGD + 4 * kq;
#define GT_DT(dt) do { s16x4 r0, r1, r2, r3, r4, r5, r6, r7; \
        TRRD(r0, vb, (dt) * 32 + 0 * 17408); TRRD(r1, vb, (dt) * 32 + 0 * 17408 + 8704); TRRD(r2, vb, (dt) * 32 + 1 * 17408); TRRD(r3, vb, (dt) * 32 + 1 * 17408 + 8704); \
        TRRD(r4, vb, (dt) * 32 + 2 * 17408); TRRD(r5, vb, (dt) * 32 + 2 * 17408 + 8704); TRRD(r6, vb, (dt) * 32 + 3 * 17408); TRRD(r7, vb, (dt) * 32 + 3 * 17408 + 8704); \
        const u32x2 uu = *(const GAS u32x2*)(urow + 16 * (dt)); \
        asm volatile("s_waitcnt lgkmcnt(0)" ::: "memory"); SBAR(); \
        f32x4 o = {0.f, 0.f, 0.f, 0.f}; \
        o = __builtin_amdgcn_mfma_f32_16x16x32_bf16(mk8(r0, r1), wf[0], o, 0, 0, 0); o = __builtin_amdgcn_mfma_f32_16x16x32_bf16(mk8(r2, r3), wf[1], o, 0, 0, 0); \
        o = __builtin_amdgcn_mfma_f32_16x16x32_bf16(mk8(r4, r5), wf[2], o, 0, 0, 0); o = __builtin_amdgcn_mfma_f32_16x16x32_bf16(mk8(r6, r7), wf[3], o, 0, 0, 0); \
        u32x2 w; w.x = pk2(bf_lo(uu.x) * (o[0] + bst), bf_hi(uu.x) * (o[1] + bst)); w.y = pk2(bf_lo(uu.y) * (o[2] + bst), bf_hi(uu.y) * (o[3] + bst)); \
        *(GAS u32x2*)(urow + 16 * (dt)) = w; } while (0)
        GT_DT(0); GT_DT(1); GT_DT(2); GT_DT(3); GT_DT(4); GT_DT(5); GT_DT(6); GT_DT(7); GT_DT(8); GT_DT(9); GT_DT(10); GT_DT(11); GT_DT(12); GT_DT(13); GT_DT(14); GT_DT(15);
#undef GT_DT
        __syncthreads();
    }
}

__device__ __forceinline__ void cmp_finalize_phase(Frame& F) {
    const float* LOHI = (const float*)(F.ws + SC_LOHI); const float* cb = (const float*)(F.ws + SM_CBIAS); bf16* KC = (bf16*)(F.ws + SC_KC);
    LAS float* hl = (LAS float*)(F.lds) + F.wave * 128;
    const int gw = F.vcu * NWAVES + F.wave, NGW = F.G * NWAVES;
    for (int r = gw; r < 2 * 8 * 1024; r += NGW) {
        const int which = r >> 13, i = r & 1023; bf16* dst = KC + (size_t)r * HD;
        if (i == 1023) { dst[F.lane] = 0; dst[F.lane + 64] = 0; continue; }
        const float* w2 = FIN(which ? I_CVW2 : I_CKW2);
        const float* lo = LOHI + (size_t)r * 256; const float* hi = lo + 256 + 128;
#pragma unroll
        for (int h = 0; h < 2; ++h) { const int n = F.lane + 64 * h; hl[n] = gelu1(lo[n] + hi[n] + cb[which * 128 + n]); }
        LDS_WAIT(); asm volatile("" ::: "memory");
        float a0 = 0.f, a1 = 0.f;
#pragma unroll 8
        for (int n = 0; n < 128; ++n) { const float h = hl[n]; a0 += h * w2[n * 128 + F.lane]; a1 += h * w2[n * 128 + 64 + F.lane]; }
        dst[F.lane] = (bf16)f2bf(a0); dst[F.lane + 64] = (bf16)f2bf(a1);
        LDS_WAIT(); asm volatile("" ::: "memory");
    }
}

constexpr int KST = 272, VST = 288, KTB = 64 * KST, VTB = 64 * VST;
struct GS { bf16x8 q[4]; f32x4 o[8]; float m, l; };
__device__ __forceinline__ void gs_init(GS& g, const bf16* qrow) {
#pragma unroll
    for (int sl = 0; sl < 4; ++sl) g.q[sl] = *(const GAS bf16x8*)(qrow + 32 * sl);
#pragma unroll
    for (int dt = 0; dt < 8; ++dt) g.o[dt] = (f32x4){0.f, 0.f, 0.f, 0.f};
    g.m = -1e30f; g.l = 0.f;
}
template <int NG> __device__ __forceinline__ void qk_tile(f32x4 (&s0)[4], f32x4 (&s1)[4], const GS& g0, const GS& g1, const LAS unsigned char* kl) {
#pragma unroll
    for (int T_ = 0; T_ < 4; ++T_) { s0[T_] = (f32x4){0.f, 0.f, 0.f, 0.f}; s1[T_] = (f32x4){0.f, 0.f, 0.f, 0.f}; }
#pragma unroll
    for (int T_ = 0; T_ < 4; ++T_)
#pragma unroll
        for (int sl = 0; sl < 4; ++sl) { const bf16x8 kf = *(const LAS bf16x8*)(kl + T_ * 16 * KST + sl * 64);
            s0[T_] = __builtin_amdgcn_mfma_f32_16x16x32_bf16(kf, g0.q[sl], s0[T_], 0, 0, 0);
            if (NG == 2) s1[T_] = __builtin_amdgcn_mfma_f32_16x16x32_bf16(kf, g1.q[sl], s1[T_], 0, 0, 0); }
}
__device__ __forceinline__ void mask_scores(f32x4 (&s)[4], int a, unsigned W, int kb, int q4) {
    const float NEG = -__builtin_inff();
#pragma unroll
    for (int T_ = 0; T_ < 4; ++T_)
#pragma unroll
        for (int i = 0; i < 4; ++i) if ((unsigned)(a - (kb + 16 * T_ + 4 * q4 + i)) >= W) s[T_][i] = NEG;
}
template <bool WITH_O> __device__ __forceinline__ void online_sm(f32x4 (&s)[4], GS& g) {
    float mx = s[0][0];
#pragma unroll
    for (int T_ = 0; T_ < 4; ++T_)
#pragma unroll
        for (int i = 0; i < 4; ++i) mx = fmaxf(mx, s[T_][i]);
    mx = fmaxf(mx, __shfl_xor(mx, 16)); mx = fmaxf(mx, __shfl_xor(mx, 32));
    const float mn = fmaxf(g.m, mx), al = __builtin_amdgcn_exp2f(g.m - mn); g.m = mn;
    float ps = 0.f;
#pragma unroll
    for (int T_ = 0; T_ < 4; ++T_)
#pragma unroll
        for (int i = 0; i < 4; ++i) { s[T_][i] = __builtin_amdgcn_exp2f(s[T_][i] - mn); ps += s[T_][i]; }
    g.l = g.l * al + ps;
    if (WITH_O) { if (__any(al < 1.f)) {
#pragma unroll
        for (int dt = 0; dt < 8; ++dt) g.o[dt] = g.o[dt] * al; } }
}
__device__ __forceinline__ bf16x8 ppack(const f32x4 a, const f32x4 b) { const u32x4 w = pack8f(a, b); return __builtin_bit_cast(bf16x8, w); }
template <int NG> __device__ __forceinline__ void pv_tile(GS& g0, GS& g1, const f32x4 (&s0)[4], const f32x4 (&s1)[4], unsigned vb) {
    const bf16x8 pa0 = ppack(s0[0], s0[1]), pa1 = ppack(s0[2], s0[3]);
    bf16x8 pb0 = pa0, pb1 = pa1; if (NG == 2) { pb0 = ppack(s1[0], s1[1]); pb1 = ppack(s1[2], s1[3]); }
#define PV_DT2(dt) do { s16x4 r0, r1, r2, r3, r4, r5, r6, r7; \
        TRRD(r0, vb, (dt) * 32); TRRD(r1, vb, (dt) * 32 + 4608); TRRD(r2, vb, (dt) * 32 + 9216); TRRD(r3, vb, (dt) * 32 + 9216 + 4608); \
        TRRD(r4, vb, (dt) * 32 + 32); TRRD(r5, vb, (dt) * 32 + 32 + 4608); TRRD(r6, vb, (dt) * 32 + 32 + 9216); TRRD(r7, vb, (dt) * 32 + 32 + 9216 + 4608); \
        asm volatile("s_waitcnt lgkmcnt(0)" ::: "memory"); SBAR(); \
        const bf16x8 v0 = mk8(r0, r1), v1 = mk8(r2, r3), v2 = mk8(r4, r5), v3 = mk8(r6, r7); \
        g0.o[dt] = __builtin_amdgcn_mfma_f32_16x16x32_bf16(v0, pa0, g0.o[dt], 0, 0, 0); g0.o[dt] = __builtin_amdgcn_mfma_f32_16x16x32_bf16(v1, pa1, g0.o[dt], 0, 0, 0); \
        g0.o[(dt) + 1] = __builtin_amdgcn_mfma_f32_16x16x32_bf16(v2, pa0, g0.o[(dt) + 1], 0, 0, 0); g0.o[(dt) + 1] = __builtin_amdgcn_mfma_f32_16x16x32_bf16(v3, pa1, g0.o[(dt) + 1], 0, 0, 0); \
        if (NG == 2) { g1.o[dt] = __builtin_amdgcn_mfma_f32_16x16x32_bf16(v0, pb0, g1.o[dt], 0, 0, 0); g1.o[dt] = __builtin_amdgcn_mfma_f32_16x16x32_bf16(v1, pb1, g1.o[dt], 0, 0, 0); \
            g1.o[(dt) + 1] = __builtin_amdgcn_mfma_f32_16x16x32_bf16(v2, pb0, g1.o[(dt) + 1], 0, 0, 0); g1.o[(dt) + 1] = __builtin_amdgcn_mfma_f32_16x16x32_bf16(v3, pb1, g1.o[(dt) + 1], 0, 0, 0); } } while (0)
    PV_DT2(0); PV_DT2(2); PV_DT2(4); PV_DT2(6);
#undef PV_DT2
}
__device__ __forceinline__ float gs_inv(const GS& g) { float l = g.l; l += __shfl_xor(l, 16); l += __shfl_xor(l, 32); return l > 0.f ? 1.f / l : 0.f; }
struct StageRegs { u32x4 k0, k1, v0, v1; };
template <bool WITH_V> __device__ __forceinline__ void stage_load(StageRegs& r, const bf16* Kp, const bf16* Vp, int tid) {
    const int i0 = tid, i1 = tid + 512;
    r.k0 = *(const GAS u32x4*)(Kp + (size_t)(i0 >> 4) * HD + (i0 & 15) * 8); r.k1 = *(const GAS u32x4*)(Kp + (size_t)(i1 >> 4) * HD + (i1 & 15) * 8);
    if (WITH_V) { r.v0 = *(const GAS u32x4*)(Vp + (size_t)(i0 >> 4) * HD + (i0 & 15) * 8); r.v1 = *(const GAS u32x4*)(Vp + (size_t)(i1 >> 4) * HD + (i1 & 15) * 8); }
}
template <bool WITH_V> __device__ __forceinline__ void stage_write(const StageRegs& r, LAS unsigned char* kt, LAS unsigned char* vt, int tid) {
    const int i0 = tid, i1 = tid + 512;
    *(LAS u32x4*)(kt + (i0 >> 4) * KST + (i0 & 15) * 16) = r.k0; *(LAS u32x4*)(kt + (i1 >> 4) * KST + (i1 & 15) * 16) = r.k1;
    if (WITH_V) { *(LAS u32x4*)(vt + (i0 >> 4) * VST + (i0 & 15) * 16) = r.v0; *(LAS u32x4*)(vt + (i1 >> 4) * VST + (i1 & 15) * 16) = r.v1; }
}
template <bool ADD> __device__ __forceinline__ void gs_store(const GS& g, float sc, bf16* orow, const bf16* add1, const bf16* add2) {
#pragma unroll
    for (int dt = 0; dt < 8; ++dt) { f32x4 v = g.o[dt] * sc;
        if (ADD) { const u32x2 a = *(const GAS u32x2*)(add1 + 16 * dt), b = *(const GAS u32x2*)(add2 + 16 * dt);
            v[0] += bf_lo(a.x) + bf_lo(b.x); v[1] += bf_hi(a.x) + bf_hi(b.x); v[2] += bf_lo(a.y) + bf_lo(b.y); v[3] += bf_hi(a.y) + bf_hi(b.y); }
        u32x2 w; w.x = pk2(v[0], v[1]); w.y = pk2(v[2], v[3]); *(GAS u32x2*)(orow + 16 * dt) = w; }
}

__device__ __forceinline__ void window_phase(Frame& F) {
    const bf16* Q = (const bf16*)(F.ws + SC_Q); const bf16* KW = (const bf16*)(F.ws + SC_KV + 4 * KVS); const bf16* VW = (const bf16*)(F.ws + SC_KV + 5 * KVS);
    bf16* OW = (bf16*)(F.ws + SC_OW); const float* gates = (const float*)(F.ws + SM_GATES);
    const int lane = F.lane, c = lane & 15, kq = lane >> 4;
    LAS unsigned char* kbuf = F.lds; LAS unsigned char* vbuf = F.lds + 2 * KTB;
    const unsigned vlane = (unsigned)((4 * kq + (c >> 2)) * VST + 8 * (c & 3)); const int klane = c * KST + 16 * kq;
    for (int unit = F.vcu; unit < 2048; unit += F.G) {
        const int bh = unit >> 8, tile = unit & 255, b = bh >> 2, kvh = bh & 3, t0 = tile * 64;
        const int tokA = t0 + 8 * F.wave + (c >> 2), head = kvh * GQ + (c & 3);
        const size_t qoff = ((size_t)(b * NH + head) * SEQ + tokA) * HD;
        GS g0, g1; gs_init(g0, Q + qoff + 8 * kq); gs_init(g1, Q + qoff + 4 * HD + 8 * kq);
        const int kb_lo = t0 >= WIN ? t0 - WIN : 0, nblk = (t0 - kb_lo) / 64 + 1;
        const bf16* Kb = KW + (size_t)bh * SEQ * HD; const bf16* Vb = VW + (size_t)bh * SEQ * HD;
        StageRegs sr; stage_load<true>(sr, Kb + (size_t)kb_lo * HD, Vb + (size_t)kb_lo * HD, F.tid);
        for (int j = 0; j < nblk; ++j) { const int kb = kb_lo + 64 * j, buf = j & 1;
            stage_write<true>(sr, kbuf + buf * KTB, vbuf + buf * VTB, F.tid);
            __syncthreads();
            if (j + 1 < nblk) stage_load<true>(sr, Kb + (size_t)(kb + 64) * HD, Vb + (size_t)(kb + 64) * HD, F.tid);
            f32x4 s0[4], s1[4];
            qk_tile<2>(s0, s1, g0, g1, kbuf + buf * KTB + klane);
            mask_scores(s0, tokA, (unsigned)WIN, kb, kq); mask_scores(s1, tokA + 4, (unsigned)WIN, kb, kq);
            online_sm<true>(s0, g0); online_sm<true>(s1, g1);
            pv_tile<2>(g0, g1, s0, s1, lds_addr(vbuf + buf * VTB) + vlane);
        }
        __syncthreads();
        const float i0 = gs_inv(g0), i1 = gs_inv(g1);
        const float ga = gates[(size_t)(b * SEQ + tokA) * 48 + head * 3 + 2], gb = gates[(size_t)(b * SEQ + tokA + 4) * 48 + head * 3 + 2];
        gs_store<false>(g0, i0 * ga, OW + qoff + 4 * kq, nullptr, nullptr); gs_store<false>(g1, i1 * gb, OW + qoff + 4 * HD + 4 * kq, nullptr, nullptr);
    }
}

constexpr int IMP_OFF = 2 * KTB + 2 * VTB, SELM_OFF = IMP_OFF + 65536;
static_assert(SELM_OFF + 2048 <= LCTL_OFF, "attention LDS map");
__device__ __forceinline__ float wave_max(float v) {
#pragma unroll
    for (int o = 1; o < 64; o <<= 1) v = fmaxf(v, __shfl_xor(v, o));
    return v;
}
__device__ __forceinline__ void imp_accum(const f32x4 (&s)[4], float& carry, LAS float* impt  , int jb, int c, int q4, int lane) {
    float rot[4];
#pragma unroll
    for (int T_ = 0; T_ < 4; ++T_) rot[T_] = __shfl(s[T_][3], (lane + 48) & 63);
#pragma unroll
    for (int T_ = 0; T_ < 4; ++T_) { const float prev = (q4 == 0) ? (T_ == 0 ? carry : rot[T_ == 0 ? 0 : T_ - 1]) : rot[T_];
        float v = (s[T_][0] + s[T_][1]) + (s[T_][2] + s[T_][3]) + prev;
        v += __shfl_xor(v, 1); v += __shfl_xor(v, 2);
        if ((c & 3) == 0) impt[jb + 4 * T_ + q4] = v; }
    carry = rot[3];
}
__device__ __forceinline__ void cmp_phase(Frame& F) {
    const bf16* Q = (const bf16*)(F.ws + SC_Q); const bf16* KC = (const bf16*)(F.ws + SC_KC); const bf16* VC = KC + (size_t)8 * 1024 * HD;
    bf16* OC = (bf16*)(F.ws + SC_OC); const float* gates = (const float*)(F.ws + SM_GATES); unsigned long long* SELM = (unsigned long long*)(F.ws + SM_SELM);
    const int lane = F.lane, c = lane & 15, kq = lane >> 4;
    LAS unsigned char* kbuf = F.lds; LAS unsigned char* vbuf = F.lds + 2 * KTB; LAS float* imp = (LAS float*)(F.lds + IMP_OFF); LAS unsigned long long* Ml = (LAS unsigned long long*)(F.lds + SELM_OFF);
    const unsigned vlane = (unsigned)((4 * kq + (c >> 2)) * VST + 8 * (c & 3)); const int klane = c * KST + 16 * kq;
    int it = 0;
    for (int unit = F.vcu; unit < 2048; unit += F.G, ++it) {
        const int bh = unit >> 8, tl = unit & 255, tile = (it & 1) ? 255 - tl : tl, b = bh >> 2, kvh = bh & 3, t0 = tile * 64, cur = tile;
        const int tokA = t0 + 8 * F.wave + (c >> 2), head = kvh * GQ + (c & 3);
        const size_t qoff = ((size_t)(b * NH + head) * SEQ + tokA) * HD;
        GS g0, g1; gs_init(g0, Q + qoff + 8 * kq); gs_init(g1, Q + qoff + 4 * HD + 8 * kq);
        const int nkt = ((4 * cur + 2) >> 6) + 1;
        const int limA = (tokA - 31) >> 4, limB = (tokA + 4 - 31) >> 4;
        const bf16* Kb = KC + (size_t)bh * 1024 * HD; const bf16* Vb = VC + (size_t)bh * 1024 * HD;
        if (F.tid < 256) { unsigned long long mv = 0ull; if (cur < 16) mv = (F.tid <= cur) ? ~0ull : 0ull; else mv = (F.tid == 0 || F.tid == cur || F.tid == cur - 1) ? ~0ull : 0ull; Ml[F.tid] = mv; }
        StageRegs sr;
        stage_load<false>(sr, Kb, Vb, F.tid);
        for (int kt = 0; kt < nkt; ++kt) { const int buf = kt & 1;
            stage_write<false>(sr, kbuf + buf * KTB, vbuf, F.tid);
            __syncthreads();
            if (kt + 1 < nkt) stage_load<false>(sr, Kb + (size_t)(kt + 1) * 64 * HD, Vb, F.tid);
            f32x4 s0[4], s1[4];
            qk_tile<2>(s0, s1, g0, g1, kbuf + buf * KTB + klane);
            mask_scores(s0, limA, 0x40000000u, kt * 64, kq); mask_scores(s1, limB, 0x40000000u, kt * 64, kq);
            online_sm<false>(s0, g0); online_sm<false>(s1, g1);
        }
        __syncthreads();
        const float i0 = gs_inv(g0), i1 = gs_inv(g1);
        float carry0 = 0.f, carry1 = 0.f;
        LAS float* impA = imp + (8 * F.wave + (c >> 2)) * 256; LAS float* impB = impA + 4 * 256;
        stage_load<true>(sr, Kb, Vb, F.tid);
        for (int kt = 0; kt < nkt; ++kt) { const int buf = kt & 1;
            stage_write<true>(sr, kbuf + buf * KTB, vbuf + buf * VTB, F.tid);
            __syncthreads();
            if (kt + 1 < nkt) stage_load<true>(sr, Kb + (size_t)(kt + 1) * 64 * HD, Vb + (size_t)(kt + 1) * 64 * HD, F.tid);
            f32x4 s0[4], s1[4];
            qk_tile<2>(s0, s1, g0, g1, kbuf + buf * KTB + klane);
            mask_scores(s0, limA, 0x40000000u, kt * 64, kq); mask_scores(s1, limB, 0x40000000u, kt * 64, kq);
#pragma unroll
            for (int T_ = 0; T_ < 4; ++T_)
#pragma unroll
                for (int i = 0; i < 4; ++i) { s0[T_][i] = __builtin_amdgcn_exp2f(s0[T_][i] - g0.m) * i0; s1[T_][i] = __builtin_amdgcn_exp2f(s1[T_][i] - g1.m) * i1; }
            imp_accum(s0, carry0, impA, kt * 16, c, kq, lane); imp_accum(s1, carry1, impB, kt * 16, c, kq, lane);
            pv_tile<2>(g0, g1, s0, s1, lds_addr(vbuf + buf * VTB) + vlane);
        }
        {   const float ga = gates[(size_t)(b * SEQ + tokA) * 48 + head * 3 + 0], gb = gates[(size_t)(b * SEQ + tokA + 4) * 48 + head * 3 + 0];
            gs_store<false>(g0, ga, OC + qoff + 4 * kq, nullptr, nullptr); gs_store<false>(g1, gb, OC + qoff + 4 * HD + 4 * kq, nullptr, nullptr); }
        LDS_WAIT(); asm volatile("" ::: "memory");
        if (cur >= 16) {
            for (int tk = 0; tk < 8; ++tk) { const int tokl = 8 * F.wave + tk; const LAS float* ir = imp + tokl * 256;
                float v[4];
#pragma unroll
                for (int i = 0; i < 4; ++i) { const int j = lane + 64 * i; v[i] = (j >= 1 && j <= cur - 2) ? ir[j] : -__builtin_inff(); }
                for (int r = 0; r < TOPN - 3; ++r) {
                    const float lm = fmaxf(fmaxf(v[0], v[1]), fmaxf(v[2], v[3])); const float wm = wave_max(lm);
                    const unsigned long long bal = __ballot(lm == wm); const int L = __ffsll((long long)bal) - 1;
                    if (lane == L) { int i = 3; if (v[2] == wm) i = 2; if (v[1] == wm) i = 1; if (v[0] == wm) i = 0;
                        if (i == 0) v[0] = -__builtin_inff(); if (i == 1) v[1] = -__builtin_inff(); if (i == 2) v[2] = -__builtin_inff(); if (i == 3) v[3] = -__builtin_inff();
                        __hip_atomic_fetch_or(Ml + (lane + 64 * i), 1ull << tokl, __ATOMIC_RELAXED, __HIP_MEMORY_SCOPE_WORKGROUP); }
                }
            }
        }
        __syncthreads();
        if (F.tid < 256) SELM[(size_t)(bh * 256 + tile) * 256 + F.tid] = Ml[F.tid];
        __syncthreads();
    }
}

__device__ __forceinline__ void sel_phase(Frame& F) {
    const bf16* Q = (const bf16*)(F.ws + SC_Q); const bf16* KS = (const bf16*)(F.ws + SC_KV + 2 * KVS); const bf16* VS = (const bf16*)(F.ws + SC_KV + 3 * KVS);
    bf16* OW = (bf16*)(F.ws + SC_OW); const bf16* OC = (const bf16*)(F.ws + SC_OC); const float* gates = (const float*)(F.ws + SM_GATES); const unsigned long long* SELM = (const unsigned long long*)(F.ws + SM_SELM);
    const int lane = F.lane, c = lane & 15, kq = lane >> 4;
    LAS unsigned char* kbuf = F.lds; LAS unsigned char* vbuf = F.lds + 2 * KTB; LAS unsigned long long* Ml = (LAS unsigned long long*)(F.lds + SELM_OFF);
    const unsigned vlane = (unsigned)((4 * kq + (c >> 2)) * VST + 8 * (c & 3)); const int klane = c * KST + 16 * kq;
    int it = 0;
    for (int unit = F.vcu; unit < 2048; unit += F.G, ++it) {
        const int bh = unit >> 8, tl = unit & 255, tile = (it & 1) ? 255 - tl : tl, b = bh >> 2, kvh = bh & 3, t0 = tile * 64, cur = tile;
        const int tokA = t0 + 8 * F.wave + (c >> 2), head = kvh * GQ + (c & 3);
        const size_t qoff = ((size_t)(b * NH + head) * SEQ + tokA) * HD;
        GS g0, g1; gs_init(g0, Q + qoff + 8 * kq); gs_init(g1, Q + qoff + 4 * HD + 8 * kq);
        if (F.tid < 256) Ml[F.tid] = SELM[(size_t)(bh * 256 + tile) * 256 + F.tid];
        const bf16* Kb = KS + (size_t)bh * SEQ * HD; const bf16* Vb = VS + (size_t)bh * SEQ * HD;
        StageRegs sr; stage_load<true>(sr, Kb, Vb, F.tid);
        __syncthreads();
        int j = 0, cnt = 0;
        while (j <= cur) { const int buf = cnt & 1;
            stage_write<true>(sr, kbuf + buf * KTB, vbuf + buf * VTB, F.tid);
            __syncthreads();
            int jn = j + 1; while (jn <= cur && Ml[jn] == 0ull) ++jn;
            if (jn <= cur) stage_load<true>(sr, Kb + (size_t)jn * 64 * HD, Vb + (size_t)jn * 64 * HD, F.tid);
            const unsigned byte = (unsigned)(Ml[j] >> (8 * F.wave)) & 0xffu; const unsigned a0 = byte & 0xfu, a1 = byte >> 4;
            const int aA = ((a0 >> (c >> 2)) & 1u) ? tokA : -1, aB = ((a1 >> (c >> 2)) & 1u) ? tokA + 4 : -1;
            const int kb = j * 64; f32x4 s0[4], s1[4];
            if (a0 != 0u && a1 != 0u) {
                qk_tile<2>(s0, s1, g0, g1, kbuf + buf * KTB + klane);
                mask_scores(s0, aA, 0x40000000u, kb, kq); mask_scores(s1, aB, 0x40000000u, kb, kq);
                online_sm<true>(s0, g0); online_sm<true>(s1, g1);
                pv_tile<2>(g0, g1, s0, s1, lds_addr(vbuf + buf * VTB) + vlane);
            } else if (a0 != 0u) {
                qk_tile<1>(s0, s1, g0, g0, kbuf + buf * KTB + klane);
                mask_scores(s0, aA, 0x40000000u, kb, kq); online_sm<true>(s0, g0);
                pv_tile<1>(g0, g0, s0, s0, lds_addr(vbuf + buf * VTB) + vlane);
            } else if (a1 != 0u) {
                qk_tile<1>(s1, s0, g1, g1, kbuf + buf * KTB + klane);
                mask_scores(s1, aB, 0x40000000u, kb, kq); online_sm<true>(s1, g1);
                pv_tile<1>(g1, g1, s1, s1, lds_addr(vbuf + buf * VTB) + vlane);
            }
            j = jn; ++cnt;
        }
        __syncthreads();
        const float i0 = gs_inv(g0), i1 = gs_inv(g1);
        const float ga = gates[(size_t)(b * SEQ + tokA) * 48 + head * 3 + 1], gb = gates[(size_t)(b * SEQ + tokA + 4) * 48 + head * 3 + 1];
        gs_store<true>(g0, i0 * ga, OW + qoff + 4 * kq, OW + qoff + 4 * kq, OC + qoff + 4 * kq);
        gs_store<true>(g1, i1 * gb, OW + qoff + 4 * HD + 4 * kq, OW + qoff + 4 * HD + 4 * kq, OC + qoff + 4 * HD + 4 * kq);
    }
}

__device__ __forceinline__ void moe_router_phase(Frame& F, int layer, const float* ssq) {
    DenseP S; S.init(F.ws + WS_HB, DM * 2, F.ws + WM_WR + (size_t)layer * 256 * DM * 2, DM, DM, T, 256, F.G, (int)blockIdx.x);
    EpiRouter E{ssq, FIN(I_RBG) + layer * NGRP, FIN(I_RBE) + layer * NEXP, (unsigned*)(F.ws + CT_CNT) + layer * 32 * 64, (int*)(F.ws + SM_LTOK), (float*)(F.ws + SM_LW), (float*)(F.ws + SM_LRS), F.LW};
    pg8::gemm_phase<EpiRouter, DenseP>(F.lds + RING_OFF, S, E, F.tid);
}
__device__ __forceinline__ int moe_setup(Frame& F, int layer) {
    const unsigned* gcnt = (const unsigned*)(F.ws + CT_CNT) + layer * 32 * 64;
    __syncthreads();
    if (F.tid < 32) F.LW[LW_CNT + F.tid] = __hip_atomic_load(gcnt + 64 * F.tid, RLX_AGENT);
    __syncthreads();
    if (F.tid == 0) { unsigned a = 0; for (int e = 0; e < 32; ++e) { F.LW[LW_BLKPRE + e] = a; a += (F.LW[LW_CNT + e] + 255u) >> 8; } F.LW[LW_BLKPRE + 32] = a; }
    __syncthreads();
    return __builtin_amdgcn_readfirstlane((int)F.LW[LW_BLKPRE + 32]);
}
__device__ __forceinline__ void moe_up_phase(Frame& F, int layer) {
    const int nblk = moe_setup(F, layer);
    MoeP S; S.A = (const char*)(F.ws + WS_HB); S.B = (const char*)(F.ws + WS_WGU); S.nt = DM / 64; S.ldb = DM; S.NP = 4; S.G = F.G; S.c = F.vcu; S.total = nblk * 4;
    S.blkpre = F.LW + LW_BLKPRE; S.cnt = F.LW + LW_CNT; S.ltok = (const int*)(F.ws + SM_LTOK); S.gather = true;
    EpiM2 E{(const float*)(F.ws + SM_LRS), (bf16*)(F.ws + SC_HID)};
    pg8::gemm_phase<EpiM2, MoeP>(F.lds + RING_OFF, S, E, F.tid);
}
__device__ __forceinline__ void moe_down_phase(Frame& F, int layer) {
    const int nblk = moe_setup(F, layer);
    MoeP S; S.A = (const char*)(F.ws + SC_HID); S.B = (const char*)(F.ws + WS_WD); S.nt = DEXP / 64; S.ldb = DEXP; S.NP = 8; S.G = F.G; S.c = F.vcu; S.total = nblk * 8;
    S.blkpre = F.LW + LW_BLKPRE; S.cnt = F.LW + LW_CNT; S.ltok = (const int*)(F.ws + SM_LTOK); S.gather = false;
    EpiM3 E{(const int*)(F.ws + SM_LTOK), (const float*)(F.ws + SM_LW), (bf16*)(F.ws + SC_Y)};
    pg8::gemm_phase<EpiM3, MoeP>(F.lds + RING_OFF, S, E, F.tid);
}

#ifndef MK_PH_LO
#define MK_PH_LO 0
#endif
#ifndef MK_PH_HI
#define MK_PH_HI 19
#endif
__global__ void __launch_bounds__(NTHR, 2) mega_fwd(Args args) {
    extern __shared__ __attribute__((aligned(16))) unsigned char lds_raw[];
    Frame F;
    F.lds = (LAS unsigned char*)lds_raw; F.LW = (volatile LAS unsigned*)(F.lds + LCTL_OFF);
    F.tid = threadIdx.x; F.lane = F.tid & 63; F.wave = __builtin_amdgcn_readfirstlane(F.tid >> 6);
#define PHASE_BEGIN() do { F.lane = lane_id_fresh(); F.tid = F.wave * 64 + F.lane; } while (0)
    F.G = gridDim.x; { const int bx = blockIdx.x; F.vcu = (F.G % 8 == 0) ? (bx % 8) * (F.G / 8) + bx / 8 : bx; }
    F.ws = args.ws; F.out = args.out;
    F.ap = &args;
    for (int u = F.tid; u < 256; u += NTHR) F.LW[u] = 0u;
    __syncthreads();
    XcdBarrier bar = xcd_barrier_post((unsigned*)(F.ws + CT_BAR) + args.li * XCD_BAR_WORDS, F.LW + LW_BAR, F.tid);
    const int lo = args.ph_lo, hi = args.ph_hi; const int BX = (int)blockIdx.x;
#ifndef MK_MASK
#define MK_MASK 0x7ffff
#endif
#define IN(k) ((((MK_MASK) >> (k)) & 1) && lo <= (k) && (k) < hi)
#define SEAM(k) do { PHASE_BEGIN(); if (IN(k) && (k) + 1 < hi && (((MK_MASK) >> ((k) + 1)) != 0)) xcd_barrier(bar, F.tid); } while (0)
    float* ssq0 = (float*)(F.ws + SM_SSQ0); float* ssq1 = (float*)(F.ws + WM_SSQP); float* ssq2 = (float*)(F.ws + SM_SSQ2); float* ssq3 = (float*)(F.ws + WM_SSQP);
    bf16* HB = (bf16*)(F.ws + WS_HB);

    if (IN(0)) { p0_prologue(F); } SEAM(0);
    if (IN(1)) {
        DenseP S; S.init(HB, DM * 2, F.ws + WM_AIN, DM, DM, T, 2 * GMW, F.G, BX);
        EpiA1 E{ssq0, (bf16*)(F.ws + SC_U), (bf16*)(F.ws + SC_V), (float*)(F.ws + SC_LNSP)};
        pg8::gemm_phase<EpiA1, DenseP>(F.lds + RING_OFF, S, E, F.tid);
    } SEAM(1);
    if (IN(2)) { gating_phase(F); } SEAM(2);
    if (IN(3)) {
        DenseP S; S.init(F.ws + SC_U, GMW * 2, F.ws + WM_AOUT, GMW, GMW, T, DM, F.G, BX);
        EpiRes E{HB, ssq1};
        pg8::gemm_phase<EpiRes, DenseP>(F.lds + RING_OFF, S, E, F.tid);
    } SEAM(3);
    if (IN(4)) { moe_router_phase(F, 0, ssq1); } SEAM(4);
    if (IN(5)) { moe_up_phase(F, 0); } SEAM(5);
    if (IN(6)) { moe_down_phase(F, 0); } SEAM(6);
    if (IN(7)) { combine_phase<false, ((MK_MASK >> 6) & 1) != 0>(F, ssq2); moe_weight_items(F, 1, F.vcu * NWAVES + F.wave, F.G * NWAVES); } SEAM(7);
    if (IN(8)) {
        DenseP S; S.init(HB, DM * 2, F.ws + WM_BIN, DM, DM, T, NSA_INP, F.G, BX);
        EpiN1 E{ssq2, (bf16*)(F.ws + SC_Q), (bf16*)(F.ws + SC_KV), (float*)(F.ws + SM_GATES)};
        pg8::gemm_phase<EpiN1, DenseP>(F.lds + RING_OFF, S, E, F.tid);
    } SEAM(8);
    if (IN(9)) {
        CmpP S; S.init(F.ws + SC_KV, 4096, F.ws + WM_C1, 2048, 2048, 8192, 256, F.G, BX);
        EpiF32 E{(float*)(F.ws + SC_LOHI)};
        pg8::gemm_phase<EpiF32, CmpP>(F.lds + RING_OFF, S, E, F.tid);
    } SEAM(9);
    if (IN(10)) { cmp_finalize_phase(F); } SEAM(10);
    if (IN(11)) { window_phase(F); } SEAM(11);
    if (IN(12)) { cmp_phase(F); } SEAM(12);
    if (IN(13)) { sel_phase(F); } SEAM(13);
    if (IN(14)) {
        HeadMajorP S; S.init(F.ws + SC_OW, 0, F.ws + WM_BOUT, DM, DM, T, DM, F.G, BX);
        EpiRes E{HB, ssq3};
        pg8::gemm_phase<EpiRes, HeadMajorP>(F.lds + RING_OFF, S, E, F.tid);
    } SEAM(14);
    if (IN(15)) { moe_router_phase(F, 1, ssq3); } SEAM(15);
    if (IN(16)) { moe_up_phase(F, 1); } SEAM(16);
    if (IN(17)) { moe_down_phase(F, 1); } SEAM(17);
    if (IN(18)) { combine_phase<true, ((MK_MASK >> 17) & 1) != 0>(F, nullptr); }
#undef IN
#undef SEAM
}

extern "C" void kernel_launch(void* const* d_in, const int* in_sizes, int n_in, void* d_out, int out_size, void* d_ws, size_t ws_size, hipStream_t stream) {
    static int grid = 0;
    if (grid == 0) {
        if (n_in != 25 || in_sizes[0] != T * DM || out_size != T * DM || ws_size < WS_END) { fprintf(stderr, "kernel_launch: unexpected shapes / workspace (n_in %d, ws %zu < %zu)\n", n_in, ws_size, (size_t)WS_END); grid = -1; return; }
        int dev = 0, cus = 0;
        if (hipGetDevice(&dev) != hipSuccess || hipDeviceGetAttribute(&cus, hipDeviceAttributeMultiprocessorCount, dev) != hipSuccess) { grid = -1; return; }
        if (hipFuncSetAttribute((const void*)mega_fwd, hipFuncAttributeMaxDynamicSharedMemorySize, LDS_BYTES) != hipSuccess) { fprintf(stderr, "kernel_launch: hipFuncSetAttribute failed\n"); grid = -1; return; }
        int per_cu = 0;
        if (hipOccupancyMaxActiveBlocksPerMultiprocessor(&per_cu, (const void*)mega_fwd, NTHR, LDS_BYTES) != hipSuccess || per_cu < 1) fprintf(stderr, "kernel_launch: occupancy query reports %d\n", per_cu);
        (void)hipGetLastError();
        grid = cus;
    }
    if (grid < 0) return;
    if (hipMemsetAsync((char*)d_ws + WS_CTL, 0, CTL_ZERO_BYTES, stream) != hipSuccess) return;
#ifdef MK_DBG_NANY
    (void)hipMemsetAsync((char*)d_ws + SC_Y, 0xFF, 256 * MiB, stream);
#endif
    Args a{};
    for (int i = 0; i < 25; ++i) a.in[i] = (const float*)d_in[i];
    a.out = (float*)d_out; a.ws = (unsigned char*)d_ws;
#ifdef MK_CUTS
    const int cuts[] = MK_CUTS;
    const int nl = (int)(sizeof(cuts) / sizeof(int)) - 1;
#else
    const int cuts[] = {MK_PH_LO, MK_PH_HI}; const int nl = 1;
#endif
    for (int li = 0; li < nl; ++li) { a.ph_lo = cuts[li]; a.ph_hi = cuts[li + 1]; a.li = li; a.pad = 0;
        hipLaunchKernelGGL(mega_fwd, dim3(grid), dim3(NTHR), LDS_BYTES, stream, a); }
}
```

```cpp
#include <hip/hip_runtime.h>
#include <cstdio>
#include <cstdint>

#define GAS __attribute__((address_space(1)))
#define LAS __attribute__((address_space(3)))
typedef unsigned short bf16;
typedef short bf16x8 __attribute__((ext_vector_type(8)));
typedef short s16x4 __attribute__((ext_vector_type(4)));
typedef float f32x4 __attribute__((ext_vector_type(4)));
typedef float f32x2 __attribute__((ext_vector_type(2)));
typedef unsigned u32x4 __attribute__((ext_vector_type(4)));
typedef unsigned u32x2 __attribute__((ext_vector_type(2)));

constexpr int DM = 2048, NB = 2, SEQ = 16384, T = NB * SEQ;
constexpr int GMW = 2048, GMG = 8, GMGD = 256, GMC = 128;
constexpr int HD = 128, NH = 16, NKV = 4, GQ = 4;
constexpr int CMPL = 32, CMPS = 16, SELB = 64, TOPN = 16, WIN = 512;
constexpr int NCMP = 1023, NSEL = 256;
constexpr int NSA_IN = 5168, NSA_INP = 5376;
constexpr int NGRP = 4, EPG = 8, NEXP = 32, DEXP = 512;
constexpr float EPSN = 1e-6f;
constexpr int LCAP = 32768;
constexpr int HIDROWS = 2 * T + NEXP * 256;

constexpr size_t MiB = 1u << 20;
constexpr size_t WS_CTL = 0, CTL_ZERO_BYTES = 2 * MiB;
constexpr size_t CT_BAR = 1 * MiB;
constexpr size_t CT_CNT = 128 * 1024;
constexpr size_t CT_SSQ1 = 256 * 1024;
constexpr size_t CT_SSQ3 = 384 * 1024;
constexpr size_t CT_LNS = 512 * 1024;
constexpr size_t WS_SMALL = 2 * MiB;
constexpr size_t SM_SSQ0 = WS_SMALL;
constexpr size_t SM_SSQ2 = SM_SSQ0 + 128 * 1024;
constexpr size_t SM_LTOK = SM_SSQ2 + 128 * 1024;
constexpr size_t SM_LW = SM_LTOK + 4 * MiB;
constexpr size_t SM_LRS = SM_LW + 4 * MiB;
constexpr size_t SM_GATES = SM_LRS + 4 * MiB;
constexpr size_t SM_CBIAS = SM_GATES + 6 * MiB;
constexpr size_t SM_SELM = SM_CBIAS + 64 * 1024;
constexpr size_t SM_END = SM_SELM + 4 * MiB;
static_assert(SM_END <= 32 * MiB, "small region");
constexpr size_t WS_WMISC = 32 * MiB;
constexpr size_t WM_AIN = WS_WMISC;
constexpr size_t WM_AOUT = WM_AIN + 16 * MiB;
constexpr size_t WM_BIN = WM_AOUT + 8 * MiB;
constexpr size_t WM_BOUT = WM_BIN + 21 * MiB;
constexpr size_t WM_C1 = WM_BOUT + 8 * MiB;
constexpr size_t WM_WR = WM_C1 + 2 * MiB;
constexpr size_t WM_WS = WM_WR + 2 * MiB;
constexpr size_t WM_SSQP = WM_WS + 1 * MiB;
constexpr size_t WM_END = WM_SSQP + 4 * MiB;
constexpr size_t WS_WGU = 96 * MiB;
constexpr size_t WS_WD = WS_WGU + 128 * MiB;
constexpr size_t WS_HB = WS_WD + 64 * MiB;
constexpr size_t WS_SCR = WS_HB + 128 * MiB;
static_assert(WM_END <= WS_WGU, "wmisc");
constexpr size_t SC_U = WS_SCR, SC_V = SC_U + 128 * MiB, SC_LNSP = SC_V + 128 * MiB;
constexpr size_t SC_HID = WS_SCR, SC_Y = SC_HID + 72 * MiB;
constexpr size_t SC_Q = WS_SCR;
constexpr size_t SC_KV = SC_Q + 128 * MiB;
constexpr size_t SC_OW = SC_KV + 192 * MiB;
constexpr size_t SC_OC = SC_OW + 128 * MiB;
constexpr size_t SC_LOHI = SC_OC + 128 * MiB;
constexpr size_t SC_KC = SC_LOHI + 16 * MiB;
constexpr size_t WS_END = SC_KC + 4 * MiB;
static_assert(SC_Y + 256 * MiB <= WS_END && WS_END <= 1100 * MiB, "ws map");

#define RLX_AGENT __ATOMIC_RELAXED, __HIP_MEMORY_SCOPE_AGENT
#define LDS_WAIT() asm volatile("s_waitcnt lgkmcnt(0)" ::: "memory")
#define VM_WAIT() asm volatile("s_waitcnt vmcnt(0)" ::: "memory")
#define SBAR() __builtin_amdgcn_sched_barrier(0)
__device__ __forceinline__ unsigned f2bf(float f) { unsigned u = __builtin_bit_cast(unsigned, f); return (u + 0x7fffu + ((u >> 16) & 1u)) >> 16; }
__device__ __forceinline__ unsigned pk2(float lo, float hi) { unsigned r; asm volatile("v_cvt_pk_bf16_f32 %0, %1, %2" : "=v"(r) : "v"(lo), "v"(hi)); return r; }
__device__ __forceinline__ float bf_lo(unsigned w) { return __builtin_bit_cast(float, w << 16); }
__device__ __forceinline__ float bf_hi(unsigned w) { return __builtin_bit_cast(float, w & 0xffff0000u); }
__device__ __forceinline__ float wave_sum(float v) {
#pragma unroll
    for (int o = 1; o < 64; o <<= 1) v += __shfl_xor(v, o);
    return v;
}
__device__ __forceinline__ f32x2 gelu_pk(f32x2 v) {
    const f32x2 av = __builtin_elementwise_abs(v), d = av * 0.2316418882f + 1.0f;
    f32x2 t; t.x = __builtin_amdgcn_rcpf(d.x); t.y = __builtin_amdgcn_rcpf(d.y);
    f32x2 q = t * 0.5307027145f + (-0.7265760135f); q = q * t + 0.7107068705f; q = q * t + (-0.142248368f); q = q * t + 0.127414796f; q = q * t;
    const f32x2 s = (v * v) * (-0.72134752044f);
    f32x2 e; e.x = __builtin_amdgcn_exp2f(s.x); e.y = __builtin_amdgcn_exp2f(s.y);
    const f32x2 m = v * (q * e), r = v - m;
    f32x2 o; o.x = v.x < 0.f ? m.x : r.x; o.y = v.y < 0.f ? m.y : r.y; return o;
}
__device__ __forceinline__ float gelu1(float x) { f32x2 r = gelu_pk((f32x2){x, 0.f}); return r.x; }
__device__ __forceinline__ int lane_id_fresh() { int l; asm volatile("v_mbcnt_lo_u32_b32 %0, -1, 0\n\tv_mbcnt_hi_u32_b32 %0, -1, %0" : "=v"(l)); return l; }
__device__ __forceinline__ float rstd_of(float ssq) { return __builtin_amdgcn_rsqf(ssq * (1.0f / DM) + EPSN); }

#define XB_TMO      128
#define XB_XCNT(j)  (256  + 64 * (j))
#define XB_XSUB(j)  (1280 + 64 * (j))
#define XB_XGEN(j)  (2304 + 64 * (j))
#define XB_TOP      3328
#define XB_TOPGEN   3392
#define XCD_BAR_WORDS 3456
#define XB_SPIN_CAP (1u << 20)
__device__ __forceinline__ unsigned xb_ld(unsigned* p)              { return __hip_atomic_load(p, __ATOMIC_RELAXED, __HIP_MEMORY_SCOPE_AGENT); }
__device__ __forceinline__ unsigned xb_add(unsigned* p, unsigned v) { return __hip_atomic_fetch_add(p, v, __ATOMIC_RELAXED, __HIP_MEMORY_SCOPE_AGENT); }
__device__ __forceinline__ unsigned xb_xcc_id() { return (unsigned)__builtin_amdgcn_s_getreg((3 << 11) | 20) & 0xFu; }
#define XB_SPIN(cond, bar) do { unsigned _sp = 0; while (cond) { __builtin_amdgcn_s_sleep(1); \
    if ((++_sp & 255u) == 0u) { if (xb_ld(&(bar)[XB_TMO])) break; if (_sp > XB_SPIN_CAP) { atomicAdd(&(bar)[XB_TMO], 1u); break; } } } } while (0)
struct XcdBarrier { unsigned* bar; unsigned x; volatile LAS unsigned* st; };
__device__ __forceinline__ XcdBarrier xcd_barrier_post(unsigned* bar, volatile LAS unsigned* st, int tid) {
    XcdBarrier b; b.bar = bar; b.x = xb_xcc_id(); b.st = st;
    if (tid == 0) (void)xb_add(&bar[XB_XCNT(b.x)], 1u);
    return b;
}
__device__ __forceinline__ void xcd_barrier_complete(unsigned* bar, unsigned x, unsigned& nloc, unsigned& nx) {
    const unsigned G = gridDim.x * gridDim.y * gridDim.z;
    unsigned sum, cnt, mine, sp = 0u;
    for (;;) {
        sum = 0u; cnt = 0u; mine = 0u;
#pragma unroll
        for (unsigned j = 0; j < 16; ++j) { const unsigned c = xb_ld(&bar[XB_XCNT(j)]); sum += c; cnt += (c > 0u) ? 1u : 0u; mine = (j == x) ? c : mine; }
        if (sum == G) break;
        __builtin_amdgcn_s_sleep(1);
        if ((++sp & 255u) == 0u) { if (xb_ld(&bar[XB_TMO])) break; if (sp > XB_SPIN_CAP) { atomicAdd(&bar[XB_TMO], 1u); break; } }
    }
    nloc = mine > 0u ? mine : 1u; nx = cnt > 0u ? cnt : 1u;
}
__device__ __forceinline__ void xcd_barrier(const XcdBarrier& b, int tid) {
    asm volatile("s_waitcnt vmcnt(0)" ::: "memory");
    __syncthreads();
    if (tid == 0) {
        unsigned* bar = b.bar;
        __builtin_amdgcn_s_waitcnt(0);
        unsigned nloc = b.st[0], nx = b.st[1];
        if (nloc == 0u) { xcd_barrier_complete(bar, b.x, nloc, nx); b.st[0] = nloc; b.st[1] = nx; }
        const unsigned old = xb_add(&bar[XB_XSUB(b.x)], 1u);
        const unsigned gen = old / nloc;
        if (old + 1u == (gen + 1u) * nloc) {
            __builtin_amdgcn_fence(__ATOMIC_RELEASE, "agent");
            asm volatile("s_waitcnt vmcnt(0)" ::: "memory");
            const unsigned og = xb_add(&bar[XB_TOP], 1u);
            const unsigned tg = og / nx;
            if (og + 1u == (tg + 1u) * nx) xb_add(&bar[XB_TOPGEN], 1u);
            else XB_SPIN(xb_ld(&bar[XB_TOPGEN]) == tg, bar);
            __builtin_amdgcn_fence(__ATOMIC_ACQUIRE, "agent");
            xb_add(&bar[XB_XGEN(b.x)], 1u);
            asm volatile("s_waitcnt vmcnt(0)" ::: "memory");
        } else {
            XB_SPIN(xb_ld(&bar[XB_XGEN(b.x)]) == gen, bar);
            __builtin_amdgcn_fence(__ATOMIC_ACQUIRE, "agent");
            asm volatile("s_waitcnt vmcnt(0)" ::: "memory");
        }
    }
    __syncthreads();
}

namespace pg8 {
constexpr int BM = 256, BK = 64, HALF = 128, HTB = HALF * BK * 2, STAGE_BYTES = 8 * HTB;
__host__ __device__ __forceinline__ int lds_byte(int r, int c) { const int st = (r >> 4) * 2 + (c >> 5), rr = r & 15, cc = c & 31, ob = rr * 64 + cc * 2; return st * 1024 + (ob ^ (((ob >> 9) & 1) << 5)); }
__host__ __device__ __forceinline__ void stage_rc(int b, int& R, int& C) { const int st = b / 1024, sb = b % 1024, swz = sb ^ (((sb >> 9) & 1) << 5); R = (st >> 1) * 16 + swz / 64; C = (st & 1) * 32 + (swz % 64) / 2; }
__host__ __device__ __forceinline__ int perm32(int rho) { const int n = rho >> 4, i = rho & 15; return 8 * (i >> 2) + 4 * n + (i & 3); }
struct Unit { int pm, pn, e, aux; };
template <class Epi, class P>
__device__ __forceinline__ void gemm_phase(LAS unsigned char* lds, const P& S, const Epi& E, const int tid) {
    const int wid = __builtin_amdgcn_readfirstlane(tid >> 6), lane = tid & 63, wr = wid >> 2, wc = wid & 3, fr = lane & 15, fq = lane >> 4;
    const int nt = S.nt;
    unsigned voffB[2];
#pragma unroll
    for (int i = 0; i < 2; ++i) { int R, C; stage_rc(tid * 16 + i * 8192, R, C); const int Rb = Epi::PERM ? ((R & ~31) + perm32(R & 31)) : R;
        voffB[i] = (unsigned)(Rb * S.ldb + C) * 2u; }
    const size_t hstepB = (size_t)HALF * S.ldb * 2;
    const unsigned ldsw = (unsigned)wid * 1024u;
    const int aoff = lds_byte(wr * 64 + fr, fq * 8), boff = lds_byte(wc * 32 + fr, fq * 8);
#define PG8_SA(b, h) (((b) * 2 + (h)) * HTB)
#define PG8_SB(b, h) ((4 + (b) * 2 + (h)) * HTB)
#define PG8_STAGE(bufoff, gbase, voff) do { _Pragma("unroll") for (int _i = 0; _i < 2; ++_i) \
        __builtin_amdgcn_global_load_lds((const unsigned*)((const char*)(gbase) + (voff)[_i]), (LAS unsigned*)(lds + (bufoff) + ldsw + _i * 8192), 16, 0, 0); } while (0)
#define PG8_LDA(dst, b, h) do { _Pragma("unroll") for (int m = 0; m < 4; ++m) _Pragma("unroll") for (int k = 0; k < 2; ++k) dst[m][k] = *(const LAS bf16x8*)(lds + PG8_SA(b, h) + aoff + m * 2048 + k * 1024); } while (0)
#define PG8_LDB(dst, b, h) do { _Pragma("unroll") for (int n = 0; n < 2; ++n) _Pragma("unroll") for (int k = 0; k < 2; ++k) dst[n][k] = *(const LAS bf16x8*)(lds + PG8_SB(b, h) + boff + n * 2048 + k * 1024); } while (0)
#define PG8_MMA(ai, bj, At, Bt) do { __builtin_amdgcn_s_setprio(1); _Pragma("unroll") for (int m = 0; m < 4; ++m) _Pragma("unroll") for (int n = 0; n < 2; ++n) _Pragma("unroll") for (int k = 0; k < 2; ++k) \
        acc[ai][bj][m][n] = __builtin_amdgcn_mfma_f32_16x16x32_bf16(Bt[n][k], At[m][k], acc[ai][bj][m][n], 0, 0, 0); __builtin_amdgcn_s_setprio(0); } while (0)
#define PG8_WAIT_V(n) asm volatile("s_waitcnt vmcnt(" #n ")" ::: "memory")
#define PG8_WAIT_L(n) asm volatile("s_waitcnt lgkmcnt(" #n ")" ::: "memory")
#define PG8_BAR __builtin_amdgcn_s_barrier()
#define PG8_SCHED __builtin_amdgcn_sched_barrier(0)
#define PG8_AOFF(dst, u) do { _Pragma("unroll") for (int _i = 0; _i < 2; ++_i) { int _R, _C; stage_rc(tid * 16 + _i * 8192, _R, _C); \
        _Pragma("unroll") for (int _h = 0; _h < 2; ++_h) dst[_h][_i] = S.a_row(u, _h * HALF + _R) + (unsigned)(_C * 2); } } while (0)
    Unit cur, nxt; int ui = 0;
    if (!S.next(0, cur)) return;
    f32x4 acc[2][2][4][2];
#pragma unroll
    for (int a = 0; a < 2; ++a)
#pragma unroll
        for (int b = 0; b < 2; ++b)
#pragma unroll
            for (int m = 0; m < 4; ++m)
#pragma unroll
                for (int n = 0; n < 2; ++n) acc[a][b][m][n] = (f32x4){0.f, 0.f, 0.f, 0.f};
    bf16x8 At[4][2], B0[2][2], B1[2][2];
    unsigned cAo[2][2], nAo[2][2];
    PG8_AOFF(cAo, cur);
    const char* cB = S.B + S.b_base(cur);
    const char* const Ab = S.A;
    {
        const char* a0 = Ab + S.a_k(0); const char* a1 = Ab + S.a_k(1);
        PG8_STAGE(PG8_SB(0, 0), cB, voffB); PG8_STAGE(PG8_SB(0, 1), cB + hstepB, voffB); PG8_STAGE(PG8_SA(0, 0), a0, cAo[0]); PG8_STAGE(PG8_SA(0, 1), a0, cAo[1]);
        if (wr == 1) PG8_BAR;
        PG8_WAIT_V(2); PG8_BAR;
        PG8_STAGE(PG8_SB(1, 0), cB + 128, voffB); PG8_STAGE(PG8_SA(1, 0), a1, cAo[0]); PG8_STAGE(PG8_SB(1, 1), cB + hstepB + 128, voffB);
        PG8_WAIT_V(6); PG8_BAR;
    }
    for (;;) {
        const bool has_next = S.next(ui + 1, nxt);
        const char* nB = cB;
        if (has_next) { PG8_AOFF(nAo, nxt); nB = S.B + S.b_base(nxt); }
        else {
#pragma unroll
            for (int _h = 0; _h < 2; ++_h)
#pragma unroll
                for (int _i = 0; _i < 2; ++_i) nAo[_h][_i] = cAo[_h][_i];
        }
        for (int t = 0; t < nt; t += 2) {
            const bool last = (t == nt - 2);
            const char* a1 = Ab + S.a_k(t + 1);
            const char* a2 = Ab + (last ? S.a_k(0) : S.a_k(t + 2)); const char* b2 = last ? nB : cB + (size_t)(t + 2) * 128;
            const char* a3 = Ab + (last ? S.a_k(1) : S.a_k(t + 3)); const char* b3 = b2 + 128;
            PG8_LDB(B0, 0, 0); PG8_LDB(B1, 0, 1); PG8_SCHED; PG8_LDA(At, 0, 0); PG8_STAGE(PG8_SA(1, 1), a1, cAo[1]);
            PG8_WAIT_V(8); PG8_WAIT_L(0); PG8_BAR; PG8_MMA(0, 0, At, B0); PG8_MMA(0, 1, At, B1); PG8_BAR; PG8_SCHED;
            PG8_LDA(At, 0, 1); PG8_STAGE(PG8_SB(0, 0), b2, voffB); PG8_STAGE(PG8_SB(0, 1), b2 + hstepB, voffB);
            if (last) { PG8_STAGE(PG8_SA(0, 0), a2, nAo[0]); } else { PG8_STAGE(PG8_SA(0, 0), a2, cAo[0]); }
            PG8_WAIT_V(8); PG8_WAIT_L(0); PG8_BAR; PG8_MMA(1, 0, At, B0); PG8_MMA(1, 1, At, B1); PG8_BAR; PG8_SCHED;
            PG8_LDB(B0, 1, 0); PG8_LDB(B1, 1, 1); PG8_SCHED; PG8_LDA(At, 1, 0);
            if (last) { PG8_STAGE(PG8_SA(0, 1), a2, nAo[1]); } else { PG8_STAGE(PG8_SA(0, 1), a2, cAo[1]); }
            PG8_WAIT_V(8); PG8_WAIT_L(0); PG8_BAR; PG8_MMA(0, 0, At, B0); PG8_MMA(0, 1, At, B1); PG8_BAR; PG8_SCHED;
            PG8_LDA(At, 1, 1); PG8_STAGE(PG8_SB(1, 0), b3, voffB); PG8_STAGE(PG8_SB(1, 1), b3 + hstepB, voffB);
            if (last) { PG8_STAGE(PG8_SA(1, 0), a3, nAo[0]); } else { PG8_STAGE(PG8_SA(1, 0), a3, cAo[0]); }
            PG8_WAIT_V(8); PG8_WAIT_L(0); PG8_BAR; PG8_MMA(1, 0, At, B0); PG8_MMA(1, 1, At, B1); PG8_BAR; PG8_SCHED;
        }
        if (wr == 0) PG8_BAR;
        if constexpr (!Epi::AFTER_DRAIN) { E(acc, cur, wr, wc, fr, fq); }
        if (!has_next) break;
#pragma unroll
        for (int a = 0; a < 2; ++a)
#pragma unroll
            for (int b = 0; b < 2; ++b)
#pragma unroll
                for (int m = 0; m < 4; ++m)
#pragma unroll
                    for (int n = 0; n < 2; ++n) acc[a][b][m][n] = (f32x4){0.f, 0.f, 0.f, 0.f};
        cur = nxt; cB = nB; ++ui;
#pragma unroll
        for (int _h = 0; _h < 2; ++_h)
#pragma unroll
            for (int _i = 0; _i < 2; ++_i) cAo[_h][_i] = nAo[_h][_i];
        if (wr == 1) PG8_BAR;
    }
    PG8_WAIT_V(0);
    PG8_BAR;
    if constexpr (Epi::AFTER_DRAIN) { E.fused(acc, cur, wr, wc, fr, fq, lds, wid, lane, tid); }
#undef PG8_SA
#undef PG8_SB
#undef PG8_STAGE
#undef PG8_LDA
#undef PG8_LDB
#undef PG8_MMA
#undef PG8_WAIT_V
#undef PG8_WAIT_L
#undef PG8_BAR
#undef PG8_SCHED
#undef PG8_AOFF
}
}

constexpr int NWAVES = 8, NTHR = 512;
constexpr int RING_OFF = 0, RING_BYTES = 131072;
constexpr int LDS_BYTES = 147456;
constexpr int LCTL_OFF = LDS_BYTES - 1024;
constexpr int LDS_DUMMY = 0;
constexpr int LW_BAR = 0;
constexpr int LW_BLKPRE = 8;
constexpr int LW_CNT = 48;
constexpr int LW_HIST = 96;
constexpr int LW_BASE = 128;

struct Args { unsigned char* ws; float* out; int ph_lo, ph_hi, li, pad; unsigned long long padq[4]; const float* in[25]; };
struct Frame {
    LAS unsigned char* lds;
    volatile LAS unsigned* LW;
    unsigned char* ws;
    int tid, lane, wave, vcu, G;
    const Args* ap;
    float* out;
};
#define CAS __attribute__((address_space(4)))
__device__ __forceinline__ const float* kin(int i) { return ((const float* const CAS*)((const CAS char*)__builtin_amdgcn_kernarg_segment_ptr() + __builtin_offsetof(Args, in)))[i]; }
#define FIN(i) kin(i)
enum { I_X = 0, I_NMIX, I_NFFN, I_NFIN, I_AWIN, I_ALNG, I_ALNB, I_AWS, I_ABS, I_AWOUT, I_BWIN, I_CKPE, I_CKW1, I_CKW2, I_CVPE, I_CVW1, I_CVW2, I_BWOUT,
       I_RWG, I_RBG, I_RWE, I_RBE, I_EWG, I_EWU, I_EWD };

__device__ __forceinline__ void tr_item(const float* W, int ldw, int k0, int n0, int nvalid, const float* gain, float scale, bf16* D, int ldd, int dk0, int drow0, LAS float* scr, int lane) {
    if (nvalid == 32 && (ldw & 3) == 0) {
        const int nq = (lane & 7) * 4, kr = lane >> 3;
#pragma unroll
        for (int i = 0; i < 8; ++i) { const int kk = 8 * i + kr; f32x4 v = *(const GAS f32x4*)(W + (size_t)(k0 + kk) * ldw + n0 + nq);
            float gs = scale; if (gain) gs *= gain[k0 + kk];
            LAS float* d = scr + kk * 33 + nq; d[0] = v[0] * gs; d[1] = v[1] * gs; d[2] = v[2] * gs; d[3] = v[3] * gs; }
    } else {
        const int nn = lane & 31;
#pragma unroll 8
        for (int i = 0; i < 32; ++i) { const int kk = 2 * i + (lane >> 5); float v = 0.f; if (nn < nvalid) v = W[(size_t)(k0 + kk) * ldw + n0 + nn];
            if (gain) v *= gain[k0 + kk]; scr[kk * 33 + nn] = v * scale; }
    }
    LDS_WAIT(); asm volatile("" ::: "memory");
    const int c = lane & 7;
#pragma unroll
    for (int j = 0; j < 4; ++j) { const int n = (lane >> 3) + 8 * j; const LAS float* s = scr + (8 * c) * 33 + n;
        u32x4 o; o.x = pk2(s[0 * 33], s[1 * 33]); o.y = pk2(s[2 * 33], s[3 * 33]); o.z = pk2(s[4 * 33], s[5 * 33]); o.w = pk2(s[6 * 33], s[7 * 33]);
        if (n < nvalid) *(GAS u32x4*)(D + (size_t)(drow0 + n) * ldd + dk0 + k0 + 8 * c) = o; }
    LDS_WAIT(); asm volatile("" ::: "memory");
}
__device__ __forceinline__ void moe_weight_items(Frame& F, int layer, int gw, int NGW) {
    LAS float* scr = (LAS float*)(F.lds + RING_OFF + F.wave * 16384);
    bf16* WGU = (bf16*)(F.ws + WS_WGU); bf16* WD = (bf16*)(F.ws + WS_WD);
    const float* gain = FIN(I_NFFN) + layer * DM;
    constexpr int IG = 32 * 16, ID = 8 * 64;
    constexpr int PER_E = 2 * IG + ID;
    for (int it = gw; it < NEXP * PER_E; it += NGW) {
        const int e = it / PER_E; int r = it % PER_E;
        if (r < 2 * IG) { const int up = r >= IG; if (up) r -= IG; const int kb = r / 16, nb = r % 16, n0 = nb * 32;
            const float* W = FIN(up ? I_EWU : I_EWG) + ((size_t)(layer * NEXP + e) * DM) * DEXP;
            tr_item(W, DEXP, kb * 64, n0, 32, gain, 1.f, WGU + (size_t)e * 1024 * DM, DM, 0, (n0 >> 7) * 256 + up * 128 + (n0 & 127), scr, F.lane);
        } else { r -= 2 * IG; const int kb = r / 64, nb = r % 64;
            const float* W = FIN(I_EWD) + ((size_t)(layer * NEXP + e) * DEXP) * DM;
            tr_item(W, DM, kb * 64, nb * 32, 32, nullptr, 1.f, WD + (size_t)e * DM * DEXP, DEXP, 0, nb * 32, scr, F.lane); }
    }
}
__device__ __forceinline__ void p0_prologue(Frame& F) {
    LAS float* scr = (LAS float*)(F.lds + RING_OFF + F.wave * 16384);
    const int gw = F.vcu * NWAVES + F.wave, NGW = F.G * NWAVES;
    bf16* AIN = (bf16*)(F.ws + WM_AIN); bf16* AOUT = (bf16*)(F.ws + WM_AOUT); bf16* BIN = (bf16*)(F.ws + WM_BIN); bf16* BOUT = (bf16*)(F.ws + WM_BOUT);
    bf16* C1 = (bf16*)(F.ws + WM_C1); bf16* WR = (bf16*)(F.ws + WM_WR); bf16* WSB = (bf16*)(F.ws + WM_WS);
    constexpr int N_AIN = 32 * 128, N_AOUT = 32 * 64, N_BIN = 32 * 162, N_BOUT = 32 * 64, N_C1 = 2 * 2 * 32 * 4, N_WRE = 2 * 32;
    constexpr int NITEMS = N_AIN + N_AOUT + N_BIN + N_BOUT + N_C1 + N_WRE;
    constexpr float QS = 0.08838834764831845f * 1.4426950408889634f;
    for (int it = gw; it < NITEMS; it += NGW) {
        int r = it;
        if (r < N_AIN) { tr_item(FIN(I_AWIN), 2 * GMW, (r / 128) * 64, (r % 128) * 32, 32, FIN(I_NMIX), 1.f, AIN, DM, 0, (r % 128) * 32, scr, F.lane); continue; } r -= N_AIN;
        if (r < N_AOUT) { tr_item(FIN(I_AWOUT), DM, (r / 64) * 64, (r % 64) * 32, 32, nullptr, 1.f, AOUT, GMW, 0, (r % 64) * 32, scr, F.lane); continue; } r -= N_AOUT;
        if (r < N_BIN) { const int nb = r % 162, n0 = nb * 32; const int nv = (NSA_IN - n0) < 32 ? (NSA_IN - n0) : 32;
            tr_item(FIN(I_BWIN), NSA_IN, (r / 162) * 64, n0, nv, FIN(I_NMIX) + DM, n0 < 2048 ? QS : 1.f, BIN, DM, 0, n0, scr, F.lane); continue; } r -= N_BIN;
        if (r < N_BOUT) { tr_item(FIN(I_BWOUT), DM, (r / 64) * 64, (r % 64) * 32, 32, nullptr, 1.f, BOUT, DM, 0, (r % 64) * 32, scr, F.lane); continue; } r -= N_BOUT;
        if (r < N_C1) { const int which = r / 256, half = (r / 128) & 1, kb = (r / 4) & 31, nb = r & 3;
            tr_item(FIN(which ? I_CVW1 : I_CKW1) + (size_t)half * 2048 * HD, HD, kb * 64, nb * 32, 32, nullptr, 1.f, C1 + (size_t)which * 256 * 2048, 2048, 0, half * 128 + nb * 32, scr, F.lane); continue; } r -= N_C1;
        { const int layer = r / 32, kb = r % 32;
          tr_item(FIN(I_RWE) + (size_t)layer * DM * NEXP, NEXP, kb * 64, 0, 32, FIN(I_NFFN) + layer * DM, 1.f, WR + (size_t)layer * 256 * DM, DM, 0, 4, scr, F.lane); }
    }
    moe_weight_items(F, 0, gw, NGW);
    const int gt = (F.vcu * NTHR) + F.tid, NGT = F.G * NTHR;
    for (int i = gt; i < 2 * NGRP * DM; i += NGT) { const int layer = i / (NGRP * DM), j = (i / DM) % NGRP, k = i % DM;
        WR[(size_t)layer * 256 * DM + (size_t)j * DM + k] = (bf16)f2bf(FIN(I_RWG)[(size_t)layer * DM * NGRP + (size_t)k * NGRP + j] * FIN(I_NFFN)[layer * DM + k]); }
    for (int i = gt; i < GMG * GMC * GMC; i += NGT) { const int t = (i / GMC) % GMC, s = i % GMC; WSB[i] = (bf16)f2bf(s <= t ? FIN(I_AWS)[i] : 0.f); }
    for (int i = gw; i < 2 * HD; i += NGW) { const int which = i / HD, n = i % HD; const float* pe = FIN(which ? I_CVPE : I_CKPE); const float* w1 = FIN(which ? I_CVW1 : I_CKW1);
        float s = 0.f; for (int k = F.lane; k < CMPL * HD; k += 64) s += pe[k] * w1[(size_t)k * HD + n]; s = wave_sum(s); if (F.lane == 0) ((float*)(F.ws + SM_CBIAS))[i] = s; }
    float* ssq0 = (float*)(F.ws + SM_SSQ0); bf16* HB = (bf16*)(F.ws + WS_HB);
    for (int m = gw; m < T; m += NGW) {
        const GAS f32x4* xr = (const GAS f32x4*)(FIN(I_X) + (size_t)m * DM) + F.lane; f32x4 v[8]; float s = 0.f;
#pragma unroll
        for (int j = 0; j < 8; ++j) { v[j] = xr[64 * j]; s += (v[j].x * v[j].x + v[j].y * v[j].y) + (v[j].z * v[j].z + v[j].w * v[j].w); }
        s = wave_sum(s); if (F.lane == 0) ssq0[m] = s;
        GAS u32x2* o8 = (GAS u32x2*)(HB + (size_t)m * DM) + F.lane;
#pragma unroll
        for (int j = 0; j < 8; ++j) { u32x2 w; w.x = pk2(v[j].x, v[j].y); w.y = pk2(v[j].z, v[j].w); o8[64 * j] = w; }
    }
}

template <bool FINAL, bool ADDY = true>
__device__ __forceinline__ void combine_phase(Frame& F, float* ssq_out) {
    const int gw = F.vcu * NWAVES + F.wave, NGW = F.G * NWAVES;
    bf16* HB = (bf16*)(F.ws + WS_HB); const bf16* Y0 = (const bf16*)(F.ws + SC_Y); const bf16* Y1 = Y0 + (size_t)T * DM;
    for (int m = gw; m < T; m += NGW) {
        const GAS u32x4* h4 = (const GAS u32x4*)(HB + (size_t)m * DM) + F.lane; const GAS u32x4* a4 = (const GAS u32x4*)(Y0 + (size_t)m * DM) + F.lane; const GAS u32x4* b4 = (const GAS u32x4*)(Y1 + (size_t)m * DM) + F.lane;
        float v[4][8]; float s = 0.f;
#pragma unroll
        for (int j = 0; j < 4; ++j) { const u32x4 h = h4[64 * j], a = a4[64 * j], b = b4[64 * j];
#pragma unroll
            for (int q = 0; q < 4; ++q) { v[j][2 * q] = bf_lo(h[q]) + (ADDY ? bf_lo(a[q]) + bf_lo(b[q]) : 0.f); v[j][2 * q + 1] = bf_hi(h[q]) + (ADDY ? bf_hi(a[q]) + bf_hi(b[q]) : 0.f); } }
        if constexpr (!FINAL) {
#pragma unroll
            for (int j = 0; j < 4; ++j) { u32x4 w;
#pragma unroll
                for (int q = 0; q < 4; ++q) { w[q] = pk2(v[j][2 * q], v[j][2 * q + 1]); const float lo = bf_lo(w[q]), hi = bf_hi(w[q]); s += lo * lo + hi * hi; }
                ((GAS u32x4*)(HB + (size_t)m * DM) + F.lane)[64 * j] = w; }
            s = wave_sum(s); if (F.lane == 0) ssq_out[m] = s;
        } else {
#pragma unroll
            for (int j = 0; j < 4; ++j)
#pragma unroll
                for (int q = 0; q < 8; ++q) s += v[j][q] * v[j][q];
            s = wave_sum(s); const float rs = rstd_of(s);
            const float* g = FIN(I_NFIN);
#pragma unroll
            for (int j = 0; j < 4; ++j) { const int c0 = 8 * F.lane + 512 * j; const f32x4 g0 = *(const f32x4*)(g + c0), g1 = *(const f32x4*)(g + c0 + 4);
                f32x4 o0 = {v[j][0] * rs * g0.x, v[j][1] * rs * g0.y, v[j][2] * rs * g0.z, v[j][3] * rs * g0.w}, o1 = {v[j][4] * rs * g1.x, v[j][5] * rs * g1.y, v[j][6] * rs * g1.z, v[j][7] * rs * g1.w};
                *(GAS f32x4*)(F.out + (size_t)m * DM + c0) = o0; *(GAS f32x4*)(F.out + (size_t)m * DM + c0 + 4) = o1; }
        }
    }
}

using pg8::Unit;
struct DenseP {
    const char* A; const char* B; int nt, ldb; unsigned lda_b;
    int nM, nN, nwg, G, c;
    __device__ __forceinline__ void init(const void* A_, unsigned lda_bytes, const void* B_, int ldb_, int K, int M, int N, int G_, int c_) {
        A = (const char*)A_; B = (const char*)B_; lda_b = lda_bytes; ldb = ldb_; nt = K / 64; nM = M / 256; nN = N / 256; nwg = nM * nN; G = G_; c = c_; }
    __device__ __forceinline__ bool next(int i, Unit& u) const {
        const long L = (long)i * G + c; if (L >= nwg) return false;
        int wgid = (int)L; { const int q = nwg / 8, r = nwg % 8, xcd = wgid % 8, off = wgid / 8; wgid = (xcd < r ? xcd * (q + 1) : r * (q + 1) + (xcd - r) * q) + off; }
        const int nig = 8 * nN, gid = wgid / nig, fm = gid * 8, gsz = (nM - fm) < 8 ? (nM - fm) : 8;
        u.pm = fm + ((wgid % nig) % gsz); u.pn = (wgid % nig) / gsz; u.e = 0; u.aux = 0; return true;
    }
    __device__ __forceinline__ unsigned a_row(const Unit& u, int r) const { return (unsigned)(u.pm * 256 + r) * lda_b; }
    __device__ __forceinline__ size_t a_k(int kt) const { return (size_t)kt * 128; }
    __device__ __forceinline__ size_t b_base(const Unit& u) const { return (size_t)u.pn * 256 * ldb * 2; }
};
struct HeadMajorP : DenseP {
    __device__ __forceinline__ unsigned a_row(const Unit& u, int r) const { const int row = u.pm * 256 + r; const int b = row / SEQ, t = row % SEQ; return (unsigned)((b * NH * SEQ + t) * (HD * 2)); }
    __device__ __forceinline__ size_t a_k(int kt) const { return (size_t)(kt >> 1) * ((size_t)SEQ * HD * 2) + (size_t)(kt & 1) * 128; }
};
constexpr size_t KVS = 32 * MiB;
struct CmpP : DenseP {
    __device__ __forceinline__ bool next(int i, Unit& u) const { const int L = i * G + c; if (L >= 64) return false; u.pm = L & 31; u.pn = 0; u.e = L >> 5; u.aux = 0; return true; }
    __device__ __forceinline__ unsigned a_row(const Unit& u, int r) const { return (unsigned)(u.e * KVS) + (unsigned)(u.pm * 256 + r) * 4096u; }
    __device__ __forceinline__ size_t b_base(const Unit& u) const { return (size_t)u.e * 256 * 2048 * 2; }
};
struct MoeP {
    const char* A; const char* B; int nt, ldb;
    int NP, G, c, total; const volatile LAS unsigned* blkpre; const volatile LAS unsigned* cnt; const int* ltok; bool gather;
    __device__ __forceinline__ bool next(int i, Unit& u) const {
        const int L = i * G + c; if (L >= total) return false;
        const int blk = L / NP; u.pn = L % NP; int e = 0;
_Pragma("unroll 1")
        for (int s = 16; s >= 1; s >>= 1) { if ((unsigned)__builtin_amdgcn_readfirstlane((int)blkpre[e + s]) <= (unsigned)blk) e += s; }
        const int mb = blk - __builtin_amdgcn_readfirstlane((int)blkpre[e]); int valid = __builtin_amdgcn_readfirstlane((int)cnt[e]) - mb * 256; valid = valid > 256 ? 256 : valid;
        u.pm = blk; u.e = e; u.aux = valid | (mb << 16); return true;
    }
    __device__ __forceinline__ unsigned a_row(const Unit& u, int r) const {
        if (gather) { const int valid = u.aux & 0xffff, mb = u.aux >> 16; const int rr = r < valid ? r : valid - 1; return (unsigned)(ltok[u.e * LCAP + mb * 256 + rr] >> 1) * (unsigned)(DM * 2); }
        return (unsigned)(u.pm * 256 + r) * (unsigned)(DEXP * 2);
    }
    __device__ __forceinline__ size_t a_k(int kt) const { return (size_t)kt * 128; }
    __device__ __forceinline__ size_t b_base(const Unit& u) const { return gather ? ((size_t)u.e * 1024 + (size_t)u.pn * 256) * DM * 2 : ((size_t)u.e * DM + (size_t)u.pn * 256) * DEXP * 2; }
};

#define EPI_ROWS(...) _Pragma("unroll") for (int ai = 0; ai < 2; ++ai) _Pragma("unroll") for (int m = 0; m < 4; ++m) { const int rl = ai * 128 + wr * 64 + m * 16 + fr; __VA_ARGS__ }
__device__ __forceinline__ u32x4 pack8f(const f32x4 a, const f32x4 b) { u32x4 w; w.x = pk2(a[0], a[1]); w.y = pk2(a[2], a[3]); w.z = pk2(b[0], b[1]); w.w = pk2(b[2], b[3]); return w; }
__device__ __forceinline__ f32x4 gelu4(f32x4 v) { const f32x2 a = gelu_pk((f32x2){v[0], v[1]}), b = gelu_pk((f32x2){v[2], v[3]}); return (f32x4){a.x, a.y, b.x, b.y}; }

struct EpiA1 {
    static constexpr bool PERM = true, AFTER_DRAIN = false;
    const float* ssq; bf16* U; bf16* V; float* lns;
    __device__ __forceinline__ void operator()(const f32x4 (&acc)[2][2][4][2], const Unit& u, int wr, int wc, int fr, int fq) const {
        const bool isv = u.pn >= 8; bf16* dst = isv ? V : U; const int colt = (isv ? u.pn - 8 : u.pn) * 256 + wc * 32 + 8 * fq;
        EPI_ROWS({ const int row = u.pm * 256 + rl; const float rs = rstd_of(ssq[row]); float s1 = 0.f, s2 = 0.f;
_Pragma("unroll")
            for (int bj = 0; bj < 2; ++bj) { const f32x4 v0 = gelu4(acc[ai][bj][m][0] * rs), v1 = gelu4(acc[ai][bj][m][1] * rs);
                *(GAS u32x4*)(dst + (size_t)row * GMW + colt + bj * 128) = pack8f(v0, v1);
                s1 += (v0[0] + v0[1]) + (v0[2] + v0[3]) + (v1[0] + v1[1]) + (v1[2] + v1[3]);
                s2 += (v0[0] * v0[0] + v0[1] * v0[1]) + (v0[2] * v0[2] + v0[3] * v0[3]) + (v1[0] * v1[0] + v1[1] * v1[1]) + (v1[2] * v1[2] + v1[3] * v1[3]); }
            if (isv) { s1 += __shfl_xor(s1, 16); s1 += __shfl_xor(s1, 32); s2 += __shfl_xor(s2, 16); s2 += __shfl_xor(s2, 32);
                if (fq == 0) *(GAS f32x2*)(lns + ((size_t)row * 32 + (u.pn - 8) * 4 + wc) * 2) = (f32x2){s1, s2}; } })
    }
};
struct EpiRes {
    static constexpr bool PERM = true, AFTER_DRAIN = false;
    bf16* HB; float* ssq;
    __device__ __forceinline__ void operator()(const f32x4 (&acc)[2][2][4][2], const Unit& u, int wr, int wc, int fr, int fq) const {
        const int colt = u.pn * 256 + wc * 32 + 8 * fq;
        EPI_ROWS({ const int row = u.pm * 256 + rl; float s2 = 0.f;
_Pragma("unroll")
            for (int bj = 0; bj < 2; ++bj) { GAS u32x4* p = (GAS u32x4*)(HB + (size_t)row * DM + colt + bj * 128); const u32x4 h = *p; u32x4 w;
                const f32x4 a0 = acc[ai][bj][m][0], a1 = acc[ai][bj][m][1];
                w.x = pk2(bf_lo(h.x) + a0[0], bf_hi(h.x) + a0[1]); w.y = pk2(bf_lo(h.y) + a0[2], bf_hi(h.y) + a0[3]);
                w.z = pk2(bf_lo(h.z) + a1[0], bf_hi(h.z) + a1[1]); w.w = pk2(bf_lo(h.w) + a1[2], bf_hi(h.w) + a1[3]);
                *p = w;
_Pragma("unroll")
                for (int q = 0; q < 4; ++q) { const float lo = bf_lo(w[q]), hi = bf_hi(w[q]); s2 += lo * lo + hi * hi; } }
            s2 += __shfl_xor(s2, 16); s2 += __shfl_xor(s2, 32);
            if (fq == 0) ssq[(size_t)row * 32 + u.pn * 4 + wc] = s2; })
    }
};
struct EpiN1 {
    static constexpr bool PERM = true, AFTER_DRAIN = false;
    const float* ssq; bf16* Q; bf16* KV; float* gates;
    __device__ __forceinline__ void operator()(const f32x4 (&acc)[2][2][4][2], const Unit& u, int wr, int wc, int fr, int fq) const {
        const int cin = wc * 32 + 8 * fq;
        if (u.pn < 20) {
            EPI_ROWS({ const int row = u.pm * 256 + rl; const float rs = rstd_of(ssq[row]); const int b = row / SEQ, t = row % SEQ;
_Pragma("unroll")
                for (int bj = 0; bj < 2; ++bj) { bf16* dst;
                    if (u.pn < 8) dst = Q + ((size_t)(b * NH + u.pn * 2 + bj) * SEQ + t) * HD;
                    else { const int idx = (u.pn - 8) >> 1, head = ((u.pn - 8) & 1) * 2 + bj; dst = (bf16*)((char*)KV + (size_t)idx * KVS) + ((size_t)(b * NKV + head) * SEQ + t) * HD; }
                    *(GAS u32x4*)(dst + cin) = pack8f(acc[ai][0 + bj][m][0] * rs, acc[ai][0 + bj][m][1] * rs); } })
        } else {
            if (cin < 48) { EPI_ROWS({ const int row = u.pm * 256 + rl; const float rs = rstd_of(ssq[row]);
                f32x4 g0 = acc[ai][0][m][0] * rs, g1 = acc[ai][0][m][1] * rs;
_Pragma("unroll")
                for (int j = 0; j < 4; ++j) { g0[j] = __builtin_amdgcn_rcpf(1.f + __builtin_amdgcn_exp2f(-1.4426950408889634f * g0[j])); g1[j] = __builtin_amdgcn_rcpf(1.f + __builtin_amdgcn_exp2f(-1.4426950408889634f * g1[j])); }
                *(GAS f32x4*)(gates + (size_t)row * 48 + cin) = g0; *(GAS f32x4*)(gates + (size_t)row * 48 + cin + 4) = g1; }) }
        }
    }
};
struct EpiF32 {
    static constexpr bool PERM = false, AFTER_DRAIN = false;
    float* C;
    __device__ __forceinline__ void operator()(const f32x4 (&acc)[2][2][4][2], const Unit& u, int wr, int wc, int fr, int fq) const {
        EPI_ROWS({ float* rowp = C + ((size_t)u.e * 8192 + u.pm * 256 + rl) * 256 + wc * 32 + 4 * fq;
_Pragma("unroll")
            for (int bj = 0; bj < 2; ++bj)
_Pragma("unroll")
                for (int n = 0; n < 2; ++n) *(GAS f32x4*)(rowp + bj * 128 + n * 16) = acc[ai][bj][m][n]; })
    }
};
struct EpiM2 {
    static constexpr bool PERM = true, AFTER_DRAIN = false;
    const float* lrs; bf16* HID;
    __device__ __forceinline__ void operator()(const f32x4 (&acc)[2][2][4][2], const Unit& u, int wr, int wc, int fr, int fq) const {
        const int valid = u.aux & 0xffff, mb = u.aux >> 16, colt = u.pn * 128 + wc * 32 + 8 * fq;
        EPI_ROWS({ float rs = 0.f; if (rl < valid) rs = lrs[u.e * LCAP + mb * 256 + rl];
            f32x4 o[2];
_Pragma("unroll")
            for (int n = 0; n < 2; ++n) { const f32x4 g = acc[ai][0][m][n] * rs, up = acc[ai][1][m][n] * rs;
_Pragma("unroll")
                for (int j = 0; j < 4; ++j) o[n][j] = g[j] * __builtin_amdgcn_rcpf(1.f + __builtin_amdgcn_exp2f(-1.4426950408889634f * g[j])) * up[j]; }
            *(GAS u32x4*)(HID + ((size_t)u.pm * 256 + rl) * DEXP + colt) = pack8f(o[0], o[1]); asm volatile("" ::: "memory"); })
    }
};
struct EpiM3 {
    static constexpr bool PERM = true, AFTER_DRAIN = false;
    const int* ltok; const float* lw; bf16* Y;
    __device__ __forceinline__ void operator()(const f32x4 (&acc)[2][2][4][2], const Unit& u, int wr, int wc, int fr, int fq) const {
        const int valid = u.aux & 0xffff, mb = u.aux >> 16, colt = u.pn * 256 + wc * 32 + 8 * fq;
        EPI_ROWS({ if (rl < valid) { const int ent = ltok[u.e * LCAP + mb * 256 + rl]; const float w = lw[u.e * LCAP + mb * 256 + rl];
            bf16* dst = Y + ((size_t)(ent & 1) * T + (size_t)(ent >> 1)) * DM + colt;
_Pragma("unroll")
            for (int bj = 0; bj < 2; ++bj) *(GAS u32x4*)(dst + bj * 128) = pack8f(acc[ai][bj][m][0] * w, acc[ai][bj][m][1] * w); } })
    }
};
struct EpiRouter {
    static constexpr bool PERM = false, AFTER_DRAIN = true;
    const float* ssq; const float* bg; const float* be; unsigned* gcnt; int* ltok; float* lw; float* lrs; volatile LAS unsigned* LW;
    __device__ __forceinline__ void fused(f32x4 (&acc)[2][2][4][2], const Unit& u, int wr, int wc, int fr, int fq, LAS unsigned char* lds, int wid, int lane, const int tid) const {
        LAS float* LG = (LAS float*)lds;
        if (wc < 2) { EPI_ROWS({
_Pragma("unroll")
            for (int n = 0; n < 2; ++n) { const int col = wc * 32 + 16 * n + 4 * fq; if (col < 48) *(LAS f32x4*)(LG + rl * 48 + col) = acc[ai][0][m][n]; } }) }
        if (tid < 32) LW[LW_HIST + tid] = 0u;
        __syncthreads();
        int e0 = 0, e1 = 0, p0 = 0, p1 = 0; float w0 = 0.f, w1 = 0.f, rs = 0.f; const int row = u.pm * 256 + tid;
        if (tid < 256) {
            { float sq = 0.f; const GAS f32x4* sp = (const GAS f32x4*)(ssq + (size_t)row * 32);
              _Pragma("unroll") for (int j = 0; j < 8; ++j) { const f32x4 v = sp[j]; sq += (v[0] + v[1]) + (v[2] + v[3]); }
              rs = rstd_of(sq); }
            float gl[4]; int gi = 0;
_Pragma("unroll")
            for (int j = 0; j < 4; ++j) gl[j] = LG[tid * 48 + j] * rs + bg[j];
_Pragma("unroll")
            for (int j = 1; j < 4; ++j) if (gl[j] > gl[gi]) gi = j;
            float gs = 0.f;
_Pragma("unroll")
            for (int j = 0; j < 4; ++j) gs += __expf(gl[j] - gl[gi]);
            const float gwt = 1.f / gs;
            float el[8];
_Pragma("unroll")
            for (int j = 0; j < 8; ++j) el[j] = LG[tid * 48 + 4 + gi * 8 + j] * rs + be[gi * 8 + j];
            int i0 = 0;
_Pragma("unroll")
            for (int j = 1; j < 8; ++j) if (el[j] > el[i0]) i0 = j;
            int i1 = (i0 == 0) ? 1 : 0;
_Pragma("unroll")
            for (int j = 0; j < 8; ++j) if (j != i0 && el[j] > el[i1]) i1 = j;
            const float r = __expf(el[i1] - el[i0]); const float q0 = 1.f / (1.f + r), q1 = r * q0;
            w0 = gwt * q0; w1 = gwt * q1; e0 = gi * 8 + i0; e1 = gi * 8 + i1;
            p0 = (int)__hip_atomic_fetch_add((LAS unsigned*)&LW[LW_HIST + e0], 1u, __ATOMIC_RELAXED, __HIP_MEMORY_SCOPE_WORKGROUP);
            p1 = (int)__hip_atomic_fetch_add((LAS unsigned*)&LW[LW_HIST + e1], 1u, __ATOMIC_RELAXED, __HIP_MEMORY_SCOPE_WORKGROUP);
        }
        __syncthreads();
        if (tid < 32) { const unsigned h = LW[LW_HIST + tid]; LW[LW_BASE + tid] = h ? __hip_atomic_fetch_add(gcnt + 64 * tid, h, __ATOMIC_RELAXED, __HIP_MEMORY_SCOPE_AGENT) : 0u; }
        __syncthreads();
        if (tid < 256) {
            const int d0 = e0 * LCAP + (int)LW[LW_BASE + e0] + p0, d1 = e1 * LCAP + (int)LW[LW_BASE + e1] + p1;
            ltok[d0] = row * 2; lw[d0] = w0; lrs[d0] = rs; ltok[d1] = row * 2 + 1; lw[d1] = w1; lrs[d1] = rs;
        }
        __syncthreads();
    }
};

#define TRRD(dst, base, off) asm volatile("ds_read_b64_tr_b16 %0, %1 offset:%2" : "=&v"(dst) : "v"(base), "i"(off) : "memory")
__device__ __forceinline__ bf16x8 mk8(s16x4 a, s16x4 b) { return (bf16x8){a[0], a[1], a[2], a[3], b[0], b[1], b[2], b[3]}; }
__device__ __forceinline__ unsigned lds_addr(const LAS void* p) { return (unsigned)(size_t)p; }

__device__ __forceinline__ void gating_phase(Frame& F) {
    const bf16* V = (const bf16*)(F.ws + SC_V); bf16* U = (bf16*)(F.ws + SC_U);
    const float* lnsp = (const float*)(F.ws + SC_LNSP); const bf16* WSB = (const bf16*)(F.ws + WM_WS);
    LAS f32x2* lst = (LAS f32x2*)(F.lds + 128 * 544);
    const float* lng = FIN(I_ALNG); const float* lnb = FIN(I_ALNB); const float* bsp = FIN(I_ABS);
    constexpr int VSTG = 544;
    LAS unsigned char* vl = F.lds;
    const int lane = F.lane, c = lane & 15, kq = lane >> 4, q = c >> 2, p = c & 3;
    const unsigned vb = lds_addr(vl) + (unsigned)((4 * kq + q) * VSTG + 8 * p);
    for (int unit = F.vcu; unit < 2048; unit += F.G) {
        const int chunk = unit >> 3, g = unit & 7, row0 = chunk * GMC;
        if (F.tid < GMC) { const GAS f32x4* sp = (const GAS f32x4*)(lnsp + (size_t)(row0 + F.tid) * 64); float s1 = 0.f, s2 = 0.f;
#pragma unroll
            for (int j = 0; j < 16; ++j) { const f32x4 v = sp[j]; s1 += v[0] + v[2]; s2 += v[1] + v[3]; }
            const float mean = s1 * (1.f / GMW); float var = s2 * (1.f / GMW) - mean * mean; var = var > 0.f ? var : 0.f;
            lst[F.tid] = (f32x2){mean, __builtin_amdgcn_rsqf(var + EPSN)}; }
        __syncthreads();
#pragma unroll 2
        for (int i = 0; i < 8; ++i) { const int idx = F.tid + 512 * i, r = idx >> 5, ch = idx & 31;
            const u32x4 raw = *(const GAS u32x4*)(V + (size_t)(row0 + r) * GMW + g * GMGD + ch * 8);
            const f32x2 st = lst[r]; const float mean = st.x, rstd = st.y;
            const f32x4 g0 = *(const f32x4*)(lng + g * GMGD + ch * 8), g1 = *(const f32x4*)(lng + g * GMGD + ch * 8 + 4), b0 = *(const f32x4*)(lnb + g * GMGD + ch * 8), b1 = *(const f32x4*)(lnb + g * GMGD + ch * 8 + 4);
            f32x4 x0 = {bf_lo(raw.x), bf_hi(raw.x), bf_lo(raw.y), bf_hi(raw.y)}, x1 = {bf_lo(raw.z), bf_hi(raw.z), bf_lo(raw.w), bf_hi(raw.w)};
            x0 = (x0 - mean) * rstd * g0 + b0; x1 = (x1 - mean) * rstd * g1 + b1;
            *(LAS u32x4*)(vl + r * VSTG + ch * 16) = pack8f(x0, x1); }
        __syncthreads();
        const bf16* wrow = WSB + ((size_t)g * GMC + 16 * F.wave + c) * GMC + 4 * kq;
        bf16x8 wf[4];
#pragma unroll
        for (int sl = 0; sl < 4; ++sl) { const u32x2 lo = *(const GAS u32x2*)(wrow + 32 * sl), hi = *(const GAS u32x2*)(wrow + 32 * sl + 16); u32x4 w = {lo.x, lo.y, hi.x, hi.y}; wf[sl] = __builtin_bit_cast(bf16x8, w); }
        const int t = row0 + 16 * F.wave + c; const float bst = bsp[g * GMC + 16 * F.wave + c];
        bf16* urow = U + (size_t)t * GMW + g * GMGD + 4 * kq;
#define GT_DT(dt) do { s16x4 r0, r1, r2, r3, r4, r5, r6, r7; \
        TRRD(r0, vb, (dt) * 32 + 0 * 17408); TRRD(r1, vb, (dt) * 32 + 0 * 17408 + 8704); TRRD(r2, vb, (dt) * 32 + 1 * 17408); TRRD(r3, vb, (dt) * 32 + 1 * 17408 + 8704); \
        TRRD(r4, vb, (dt) * 32 + 2 * 17408); TRRD(r5, vb, (dt) * 32 + 2 * 17408 + 8704); TRRD(r6, vb, (dt) * 32 + 3 * 17408); TRRD(r7, vb, (dt) * 32 + 3 * 17408 + 8704); \
        const u32x2 uu = *(const GAS u32x2*)(urow + 16 * (dt)); \
        asm volatile("s_waitcnt lgkmcnt(0)" ::: "memory"); SBAR(); \
        f32x4 o = {0.f, 0.f, 0.f, 0.f}; \
        o = __builtin_amdgcn_mfma_f32_16x16x32_bf16(mk8(r0, r1), wf[0], o, 0, 0, 0); o = __builtin_amdgcn_mfma_f32_16x16x32_bf16(mk8(r2, r3), wf[1], o, 0, 0, 0); \
        o = __builtin_amdgcn_mfma_f32_16x16x32_bf16(mk8(r4, r5), wf[2], o, 0, 0, 0); o = __builtin_amdgcn_mfma_f32_16x16x32_bf16(mk8(r6, r7), wf[3], o, 0, 0, 0); \
        u32x2 w; w.x = pk2(bf_lo(uu.x) * (o[0] + bst), bf_hi(uu.x) * (o[1] + bst)); w.y = pk2(bf_lo(uu.y) * (o[2] + bst), bf_hi(uu.y) * (o[3] + bst)); \
        *(GAS u32x2*)(urow + 16 * (dt)) = w; } while (0)
        GT_DT(0); GT_DT(1); GT_DT(2); GT_DT(3); GT_DT(4); GT_DT(5); GT_DT(6); GT_DT(7); GT_DT(8); GT_DT(9); GT_DT(10); GT_DT(11); GT_DT(12); GT_DT(13); GT_DT(14); GT_DT(15);
#undef GT_DT
        __syncthreads();
    }
}

__device__ __forceinline__ void cmp_finalize_phase(Frame& F) {
    const float* LOHI = (const float*)(F.ws + SC_LOHI); const float* cb = (const float*)(F.ws + SM_CBIAS); bf16* KC = (bf16*)(F.ws + SC_KC);
    LAS float* hl = (LAS float*)(F.lds) + F.wave * 128;
    const int gw = F.vcu * NWAVES + F.wave, NGW = F.G * NWAVES;
    for (int r = gw; r < 2 * 8 * 1024; r += NGW) {
        const int which = r >> 13, i = r & 1023; bf16* dst = KC + (size_t)r * HD;
        if (i == 1023) { dst[F.lane] = 0; dst[F.lane + 64] = 0; continue; }
        const float* w2 = FIN(which ? I_CVW2 : I_CKW2);
        const float* lo = LOHI + (size_t)r * 256; const float* hi = lo + 256 + 128;
#pragma unroll
        for (int h = 0; h < 2; ++h) { const int n = F.lane + 64 * h; hl[n] = gelu1(lo[n] + hi[n] + cb[which * 128 + n]); }
        LDS_WAIT(); asm volatile("" ::: "memory");
        float a0 = 0.f, a1 = 0.f;
#pragma unroll 8
        for (int n = 0; n < 128; ++n) { const float h = hl[n]; a0 += h * w2[n * 128 + F.lane]; a1 += h * w2[n * 128 + 64 + F.lane]; }
        dst[F.lane] = (bf16)f2bf(a0); dst[F.lane + 64] = (bf16)f2bf(a1);
        LDS_WAIT(); asm volatile("" ::: "memory");
    }
}

constexpr int KST = 272, VST = 288, KTB = 64 * KST, VTB = 64 * VST;
struct GS { bf16x8 q[4]; f32x4 o[8]; float m, l; };
__device__ __forceinline__ void gs_init(GS& g, const bf16* qrow) {
#pragma unroll
    for (int sl = 0; sl < 4; ++sl) g.q[sl] = *(const GAS bf16x8*)(qrow + 32 * sl);
#pragma unroll
    for (int dt = 0; dt < 8; ++dt) g.o[dt] = (f32x4){0.f, 0.f, 0.f, 0.f};
    g.m = -1e30f; g.l = 0.f;
}
template <int NG, bool HALVES = false> __device__ __forceinline__ void qk_tile(f32x4 (&s0)[4], f32x4 (&s1)[4], const GS& g0, const GS& g1, const LAS unsigned char* kl) {
#pragma unroll
    for (int T_ = 0; T_ < 4; ++T_) { s0[T_] = (f32x4){0.f, 0.f, 0.f, 0.f}; s1[T_] = (f32x4){0.f, 0.f, 0.f, 0.f}; }
    if constexpr (!HALVES) {
        bf16x8 kf[4][4];
#pragma unroll
        for (int T_ = 0; T_ < 4; ++T_)
#pragma unroll
            for (int sl = 0; sl < 4; ++sl) kf[T_][sl] = *(const LAS bf16x8*)(kl + T_ * 16 * KST + sl * 64);
        asm volatile("s_waitcnt lgkmcnt(0)" ::: "memory"); SBAR();
#pragma unroll
        for (int sl = 0; sl < 4; ++sl)
#pragma unroll
            for (int T_ = 0; T_ < 4; ++T_) {
                s0[T_] = __builtin_amdgcn_mfma_f32_16x16x32_bf16(kf[T_][sl], g0.q[sl], s0[T_], 0, 0, 0);
                if (NG == 2) s1[T_] = __builtin_amdgcn_mfma_f32_16x16x32_bf16(kf[T_][sl], g1.q[sl], s1[T_], 0, 0, 0); }
    } else {
#pragma unroll
        for (int hh = 0; hh < 2; ++hh) { bf16x8 kf[2][4];
#pragma unroll
            for (int T_ = 0; T_ < 2; ++T_)
#pragma unroll
                for (int sl = 0; sl < 4; ++sl) kf[T_][sl] = *(const LAS bf16x8*)(kl + (2 * hh + T_) * 16 * KST + sl * 64);
            asm volatile("s_waitcnt lgkmcnt(0)" ::: "memory"); SBAR();
#pragma unroll
            for (int sl = 0; sl < 4; ++sl)
#pragma unroll
                for (int T_ = 0; T_ < 2; ++T_) {
                    s0[2 * hh + T_] = __builtin_amdgcn_mfma_f32_16x16x32_bf16(kf[T_][sl], g0.q[sl], s0[2 * hh + T_], 0, 0, 0);
                    if (NG == 2) s1[2 * hh + T_] = __builtin_amdgcn_mfma_f32_16x16x32_bf16(kf[T_][sl], g1.q[sl], s1[2 * hh + T_], 0, 0, 0); } }
    }
}
__device__ __forceinline__ void mask_scores(f32x4 (&s)[4], int a, unsigned W, int kb, int q4) {
    const float NEG = -__builtin_inff();
#pragma unroll
    for (int T_ = 0; T_ < 4; ++T_)
#pragma unroll
        for (int i = 0; i < 4; ++i) if ((unsigned)(a - (kb + 16 * T_ + 4 * q4 + i)) >= W) s[T_][i] = NEG;
}
constexpr float SM_THR = 8.f;
template <bool WITH_O> __device__ __forceinline__ void online_sm(f32x4 (&s)[4], GS& g, const float rowbias = 0.f) {
    float mx = s[0][0];
#pragma unroll
    for (int T_ = 0; T_ < 4; ++T_)
#pragma unroll
        for (int i = 0; i < 4; ++i) mx = fmaxf(mx, s[T_][i]);
    mx += rowbias;
    float mn = g.m;
    if (!__all(mx <= g.m + SM_THR)) {
        mx = fmaxf(mx, __shfl_xor(mx, 16)); mx = fmaxf(mx, __shfl_xor(mx, 32));
        mn = fmaxf(g.m, mx); const float al = __builtin_amdgcn_exp2f(g.m - mn); g.m = mn; g.l *= al;
        if (WITH_O) {
#pragma unroll
            for (int dt = 0; dt < 8; ++dt) g.o[dt] = g.o[dt] * al; }
    }
    float ps = 0.f;
#pragma unroll
    for (int T_ = 0; T_ < 4; ++T_)
#pragma unroll
        for (int i = 0; i < 4; ++i) { s[T_][i] = __builtin_amdgcn_exp2f(s[T_][i] + (rowbias - mn)); ps += s[T_][i]; }
    g.l += ps;
}
__device__ __forceinline__ bf16x8 ppack(const f32x4 a, const f32x4 b) { const u32x4 w = pack8f(a, b); return __builtin_bit_cast(bf16x8, w); }
template <int NG> __device__ __forceinline__ void pv_tile(GS& g0, GS& g1, const f32x4 (&s0)[4], const f32x4 (&s1)[4], unsigned vb) {
    const bf16x8 pa0 = ppack(s0[0], s0[1]), pa1 = ppack(s0[2], s0[3]);
    bf16x8 pb0 = pa0, pb1 = pa1; if (NG == 2) { pb0 = ppack(s1[0], s1[1]); pb1 = ppack(s1[2], s1[3]); }
    s16x4 r[8][4];
#define PV_RD(dt) do { TRRD(r[dt][0], vb, (dt) * 32); TRRD(r[dt][1], vb, (dt) * 32 + 4608); TRRD(r[dt][2], vb, (dt) * 32 + 9216); TRRD(r[dt][3], vb, (dt) * 32 + 9216 + 4608); } while (0)
#define PV_MM(dt) do { const bf16x8 v0 = mk8(r[dt][0], r[dt][1]), v1 = mk8(r[dt][2], r[dt][3]); \
        g0.o[dt] = __builtin_amdgcn_mfma_f32_16x16x32_bf16(v0, pa0, g0.o[dt], 0, 0, 0); g0.o[dt] = __builtin_amdgcn_mfma_f32_16x16x32_bf16(v1, pa1, g0.o[dt], 0, 0, 0); \
        if (NG == 2) { g1.o[dt] = __builtin_amdgcn_mfma_f32_16x16x32_bf16(v0, pb0, g1.o[dt], 0, 0, 0); g1.o[dt] = __builtin_amdgcn_mfma_f32_16x16x32_bf16(v1, pb1, g1.o[dt], 0, 0, 0); } } while (0)
#define PV_W(n) asm volatile("s_waitcnt lgkmcnt(" #n ")" ::: "memory"); SBAR()
    PV_RD(0); PV_RD(1); PV_RD(2);
    PV_W(8); PV_MM(0); SBAR(); PV_RD(3);
    PV_W(8); PV_MM(1); SBAR(); PV_RD(4);
    PV_W(8); PV_MM(2); SBAR(); PV_RD(5);
    PV_W(8); PV_MM(3); SBAR(); PV_RD(6);
    PV_W(8); PV_MM(4); SBAR(); PV_RD(7);
    PV_W(8); PV_MM(5); PV_W(4); PV_MM(6); PV_W(0); PV_MM(7);
#undef PV_W
#undef PV_RD
#undef PV_MM
}
__device__ __forceinline__ float gs_inv(const GS& g) { float l = g.l; l += __shfl_xor(l, 16); l += __shfl_xor(l, 32); return l > 0.f ? 1.f / l : 0.f; }
template <bool ADD> __device__ __forceinline__ void gs_store(const GS& g, float sc, bf16* orow, const bf16* add1, const bf16* add2) {
#pragma unroll
    for (int dt = 0; dt < 8; ++dt) { f32x4 v = g.o[dt] * sc;
        if (ADD) { const u32x2 a = *(const GAS u32x2*)(add1 + 16 * dt), b = *(const GAS u32x2*)(add2 + 16 * dt);
            v[0] += bf_lo(a.x) + bf_lo(b.x); v[1] += bf_hi(a.x) + bf_hi(b.x); v[2] += bf_lo(a.y) + bf_lo(b.y); v[3] += bf_hi(a.y) + bf_hi(b.y); }
        u32x2 w; w.x = pk2(v[0], v[1]); w.y = pk2(v[2], v[3]); *(GAS u32x2*)(orow + 16 * dt) = w; }
}

constexpr int SLOT = KTB + VTB, NSLOT = 4, RING_ML_OFF = NSLOT * SLOT;
static_assert(RING_ML_OFF + 2048 <= LCTL_OFF, "ring LDS map");
struct RingLane { unsigned so[5]; };
__device__ __forceinline__ void ring_lane_init(RingLane& R, int wave, int lane) {
#pragma unroll
    for (int k = 0; k < 5; ++k) { const int n = wave + 8 * k; int row, ch;
        if (n < 17) { const int o = n * 1024 + lane * 16; row = o / KST; ch = (o % KST) >> 4; } else { const int o = (n - 17) * 1024 + lane * 16; row = o / VST; ch = (o % VST) >> 4; }
        if (ch > 15) ch = 15; if (row > 63) row = 63;
        R.so[k] = (unsigned)(row * 256 + ch * 16); }
}
__device__ __forceinline__ void ring_dma(const RingLane& R, const char* Kp, const char* Vp, LAS unsigned char* sb, int wave) {
    __builtin_amdgcn_global_load_lds((const unsigned*)(Kp + R.so[0]), (LAS unsigned*)(sb + wave * 1024), 16, 0, 0);
    __builtin_amdgcn_global_load_lds((const unsigned*)(Kp + R.so[1]), (LAS unsigned*)(sb + (wave + 8) * 1024), 16, 0, 0);
    __builtin_amdgcn_global_load_lds((const unsigned*)((wave == 0 ? Kp : Vp) + R.so[2]), (LAS unsigned*)(sb + (wave + 16) * 1024), 16, 0, 0);
    __builtin_amdgcn_global_load_lds((const unsigned*)(Vp + R.so[3]), (LAS unsigned*)(sb + (wave + 24) * 1024), 16, 0, 0);
    if (wave <= 2) __builtin_amdgcn_global_load_lds((const unsigned*)(Vp + R.so[4]), (LAS unsigned*)(sb + (wave + 32) * 1024), 16, 0, 0);
}
__device__ __forceinline__ void ring_wait(int ahead, int wave) {
    if (ahead >= 2) { if (wave <= 2) asm volatile("s_waitcnt vmcnt(10)" ::: "memory"); else asm volatile("s_waitcnt vmcnt(8)" ::: "memory"); }
    else if (ahead == 1) { if (wave <= 2) asm volatile("s_waitcnt vmcnt(5)" ::: "memory"); else asm volatile("s_waitcnt vmcnt(4)" ::: "memory"); }
    else asm volatile("s_waitcnt vmcnt(0)" ::: "memory");
}

#define RING_BARRIER() do { asm volatile("s_waitcnt lgkmcnt(0)" ::: "memory"); __builtin_amdgcn_s_barrier(); asm volatile("" ::: "memory"); } while (0)
__device__ __forceinline__ void window_phase(Frame& F) {
    const bf16* Q = (const bf16*)(F.ws + SC_Q); const char* KW = (const char*)(F.ws + SC_KV + 4 * KVS); const char* VW = (const char*)(F.ws + SC_KV + 5 * KVS);
    bf16* OW = (bf16*)(F.ws + SC_OW); const float* gates = (const float*)(F.ws + SM_GATES);
    const int lane = F.lane, c = lane & 15, kq = lane >> 4;
    const unsigned vlane = (unsigned)((4 * kq + (c >> 2)) * VST + 8 * (c & 3)); const int klane = c * KST + 16 * kq;
    RingLane RL; ring_lane_init(RL, F.wave, lane);
    for (int unit = F.vcu; unit < 2048; unit += F.G) {
        const int bh = unit >> 8, tile = unit & 255, b = bh >> 2, kvh = bh & 3, t0 = tile * 64;
        const int tokA = t0 + 8 * F.wave + (c >> 2), head = kvh * GQ + (c & 3);
        const size_t qoff = ((size_t)(b * NH + head) * SEQ + tokA) * HD;
        GS g0, g1; gs_init(g0, Q + qoff + 8 * kq); gs_init(g1, Q + qoff + 4 * HD + 8 * kq);
        const int kb_lo = t0 >= WIN ? t0 - WIN : 0, nblk = (t0 - kb_lo) / 64 + 1;
        const char* Kb = KW + ((size_t)bh * SEQ + kb_lo) * HD * 2; const char* Vb = VW + ((size_t)bh * SEQ + kb_lo) * HD * 2;
        int nis = 0;
#pragma unroll 1
        for (int p = 0; p < 3; ++p) if (nis < nblk) { ring_dma(RL, Kb + (size_t)nis * 16384, Vb + (size_t)nis * 16384, F.lds + (nis & 3) * SLOT, F.wave); ++nis; }
        for (int j = 0; j < nblk; ++j) { const int kb = kb_lo + 64 * j;
            ring_wait(nis - j - 1, F.wave); RING_BARRIER();
            if (nis < nblk) { ring_dma(RL, Kb + (size_t)nis * 16384, Vb + (size_t)nis * 16384, F.lds + (nis & 3) * SLOT, F.wave); ++nis; }
            LAS unsigned char* sb = F.lds + (j & 3) * SLOT;
            f32x4 s0[4], s1[4];
            qk_tile<2>(s0, s1, g0, g1, sb + klane);
            if (j == 0 || j == nblk - 1) { mask_scores(s0, tokA, (unsigned)WIN, kb, kq); mask_scores(s1, tokA + 4, (unsigned)WIN, kb, kq); }
            online_sm<true>(s0, g0); online_sm<true>(s1, g1);
            pv_tile<2>(g0, g1, s0, s1, lds_addr(sb + KTB) + vlane);
        }
        RING_BARRIER();
        const float i0 = gs_inv(g0), i1 = gs_inv(g1);
        const float ga = gates[(size_t)(b * SEQ + tokA) * 48 + head * 3 + 2], gb = gates[(size_t)(b * SEQ + tokA + 4) * 48 + head * 3 + 2];
        gs_store<false>(g0, i0 * ga, OW + qoff + 4 * kq, nullptr, nullptr); gs_store<false>(g1, i1 * gb, OW + qoff + 4 * HD + 4 * kq, nullptr, nullptr);
    }
}

constexpr int IMP_OFF = 2 * (KTB + VTB), SELM_OFF = IMP_OFF + 65536;
static_assert(SELM_OFF + 2048 <= LCTL_OFF, "attention LDS map");
__device__ __forceinline__ float wave_max(float v) {
#pragma unroll
    for (int o = 1; o < 64; o <<= 1) v = fmaxf(v, __shfl_xor(v, o));
    return v;
}
__device__ __forceinline__ void imp_accum(const f32x4 (&s)[4], float& carry, LAS float* impt  , int jb, int c, int q4, int lane) {
    float rot[4];
#pragma unroll
    for (int T_ = 0; T_ < 4; ++T_) rot[T_] = __shfl(s[T_][3], (lane + 48) & 63);
#pragma unroll
    for (int T_ = 0; T_ < 4; ++T_) { const float prev = (q4 == 0) ? (T_ == 0 ? carry : rot[T_ == 0 ? 0 : T_ - 1]) : rot[T_];
        float v = (s[T_][0] + s[T_][1]) + (s[T_][2] + s[T_][3]) + prev;
        v += __shfl_xor(v, 1); v += __shfl_xor(v, 2);
        if ((c & 3) == 0) impt[jb + 4 * T_ + q4] = v; }
    carry = rot[3];
}
__device__ __forceinline__ void cmp_phase(Frame& F) {
    const bf16* Q = (const bf16*)(F.ws + SC_Q); const char* KC = (const char*)(F.ws + SC_KC); const char* VC = KC + (size_t)8 * 1024 * HD * 2;
    bf16* OC = (bf16*)(F.ws + SC_OC); const float* gates = (const float*)(F.ws + SM_GATES); unsigned long long* SELM = (unsigned long long*)(F.ws + SM_SELM);
    const int lane = F.lane, c = lane & 15, kq = lane >> 4;
    LAS float* imp = (LAS float*)(F.lds + IMP_OFF); LAS unsigned long long* Ml = (LAS unsigned long long*)(F.lds + SELM_OFF);
    const unsigned vlane = (unsigned)((4 * kq + (c >> 2)) * VST + 8 * (c & 3)); const int klane = c * KST + 16 * kq;
    RingLane RL; ring_lane_init(RL, F.wave, lane);
    int it = 0;
    for (int unit = F.vcu; unit < 2048; unit += F.G, ++it) {
        const int bh = unit >> 8, tl = unit & 255, tile = (it & 1) ? 255 - tl : tl, b = bh >> 2, kvh = bh & 3, t0 = tile * 64, cur = tile;
        const int tokA = t0 + 8 * F.wave + (c >> 2), head = kvh * GQ + (c & 3);
        const size_t qoff = ((size_t)(b * NH + head) * SEQ + tokA) * HD;
        GS g0, g1; gs_init(g0, Q + qoff + 8 * kq); gs_init(g1, Q + qoff + 4 * HD + 8 * kq);
        const int nkt = ((4 * cur + 2) >> 6) + 1, nit = 2 * nkt;
        const int limA = (tokA - 31) >> 4, limB = (tokA + 4 - 31) >> 4;
        const char* Kb = KC + (size_t)bh * 1024 * HD * 2; const char* Vb = VC + (size_t)bh * 1024 * HD * 2;
        if (F.tid < 256) { unsigned long long mv = 0ull; if (cur < 16) mv = (F.tid <= cur) ? ~0ull : 0ull; else mv = (F.tid == 0 || F.tid == cur || F.tid == cur - 1) ? ~0ull : 0ull; Ml[F.tid] = mv; }
        float i0 = 0.f, i1 = 0.f, carry0 = 0.f, carry1 = 0.f;
        LAS float* impA = imp + (8 * F.wave + (c >> 2)) * 256; LAS float* impB = impA + 4 * 256;
        ring_dma(RL, Kb, Vb, F.lds, F.wave);
        for (int i = 0; i < nit; ++i) { const int kt = i < nkt ? i : i - nkt;
            asm volatile("s_waitcnt vmcnt(0)" ::: "memory"); RING_BARRIER();
            if (i + 1 < nit) { const int kn = (i + 1 < nkt) ? i + 1 : i + 1 - nkt; ring_dma(RL, Kb + (size_t)kn * 16384, Vb + (size_t)kn * 16384, F.lds + ((i + 1) & 1) * SLOT, F.wave); }
            LAS unsigned char* sb = F.lds + (i & 1) * SLOT;
            if (i == nkt) { i0 = gs_inv(g0); i1 = gs_inv(g1); }
            f32x4 s0[4], s1[4];
            qk_tile<2>(s0, s1, g0, g1, sb + klane);
            mask_scores(s0, limA, 0x40000000u, kt * 64, kq); mask_scores(s1, limB, 0x40000000u, kt * 64, kq);
            if (i < nkt) { online_sm<false>(s0, g0); online_sm<false>(s1, g1); }
            else {
#pragma unroll
                for (int T_ = 0; T_ < 4; ++T_)
#pragma unroll
                    for (int q = 0; q < 4; ++q) { s0[T_][q] = __builtin_amdgcn_exp2f(s0[T_][q] - g0.m) * i0; s1[T_][q] = __builtin_amdgcn_exp2f(s1[T_][q] - g1.m) * i1; }
                imp_accum(s0, carry0, impA, kt * 16, c, kq, lane); imp_accum(s1, carry1, impB, kt * 16, c, kq, lane);
                pv_tile<2>(g0, g1, s0, s1, lds_addr(sb + KTB) + vlane);
            }
        }
        {   const float ga = gates[(size_t)(b * SEQ + tokA) * 48 + head * 3 + 0], gb = gates[(size_t)(b * SEQ + tokA + 4) * 48 + head * 3 + 0];
            gs_store<false>(g0, ga, OC + qoff + 4 * kq, nullptr, nullptr); gs_store<false>(g1, gb, OC + qoff + 4 * HD + 4 * kq, nullptr, nullptr); }
        LDS_WAIT(); asm volatile("" ::: "memory");
        if (cur >= 16) {
            for (int tk = 0; tk < 8; ++tk) { const int tokl = 8 * F.wave + tk; const LAS float* ir = imp + tokl * 256;
                float v[4];
#pragma unroll
                for (int q = 0; q < 4; ++q) { const int j = lane + 64 * q; v[q] = (j >= 1 && j <= cur - 2) ? ir[j] : -__builtin_inff(); }
                for (int r = 0; r < TOPN - 3; ++r) {
                    const float lm = fmaxf(fmaxf(v[0], v[1]), fmaxf(v[2], v[3])); const float wm = wave_max(lm);
                    const unsigned long long bal = __ballot(lm == wm); const int L = __ffsll((long long)bal) - 1;
                    if (lane == L) { int q = 3; if (v[2] == wm) q = 2; if (v[1] == wm) q = 1; if (v[0] == wm) q = 0;
                        if (q == 0) v[0] = -__builtin_inff(); if (q == 1) v[1] = -__builtin_inff(); if (q == 2) v[2] = -__builtin_inff(); if (q == 3) v[3] = -__builtin_inff();
                        __hip_atomic_fetch_or(Ml + (lane + 64 * q), 1ull << tokl, __ATOMIC_RELAXED, __HIP_MEMORY_SCOPE_WORKGROUP); }
                }
            }
        }
        __syncthreads();
        if (F.tid < 256) SELM[(size_t)(bh * 256 + tile) * 256 + F.tid] = Ml[F.tid];
        __syncthreads();
    }
}

constexpr int RING_LIST_OFF = RING_ML_OFF + 2048;
static_assert(RING_LIST_OFF + 512 + 16 <= LCTL_OFF, "sel LDS map");
#ifndef MK_EXP
#define MK_EXP 0
#endif
template <bool DUMMY> __device__ __forceinline__ void sel_phase(Frame& F) {
    const bf16* Q = (const bf16*)(F.ws + SC_Q); const char* KS = (const char*)(F.ws + SC_KV + 2 * KVS); const char* VS = (const char*)(F.ws + SC_KV + 3 * KVS);
    bf16* OW = (bf16*)(F.ws + SC_OW); const bf16* OC = (const bf16*)(F.ws + SC_OC); const float* gates = (const float*)(F.ws + SM_GATES); const unsigned long long* SELM = (const unsigned long long*)(F.ws + SM_SELM);
    const int lane = F.lane, c = lane & 15, kq = lane >> 4;
    LAS unsigned long long* Ml = (LAS unsigned long long*)(F.lds + RING_ML_OFF);
    LAS unsigned short* Lst = (LAS unsigned short*)(F.lds + RING_LIST_OFF); LAS unsigned* Wc = (LAS unsigned*)(F.lds + RING_LIST_OFF + 512);
    const unsigned vlane = (unsigned)((4 * kq + (c >> 2)) * VST + 8 * (c & 3)); const int klane = c * KST + 16 * kq;
    RingLane RL; ring_lane_init(RL, F.wave, lane);
    int it = 0;
    for (int unit = F.vcu; unit < 2048; unit += F.G, ++it) {
        const int bh = unit >> 8, tl = unit & 255, tile = (it & 1) ? 255 - tl : tl, b = bh >> 2, kvh = bh & 3, t0 = tile * 64, cur = tile;
        const int tokA = t0 + 8 * F.wave + (c >> 2), head = kvh * GQ + (c & 3);
        const size_t qoff = ((size_t)(b * NH + head) * SEQ + tokA) * HD;
        GS g0, g1; gs_init(g0, Q + qoff + 8 * kq); gs_init(g1, Q + qoff + 4 * HD + 8 * kq);
        unsigned long long mym = 0ull; if (F.tid < 256) { mym = SELM[(size_t)(bh * 256 + tile) * 256 + F.tid]; Ml[F.tid] = mym; }
        const unsigned long long bal = __ballot(mym != 0ull && F.tid <= cur);
        if (F.wave < 4 && lane == 0) Wc[F.wave] = (unsigned)__popcll(bal);
        __syncthreads();
        if (F.tid < 256 && mym != 0ull && F.tid <= cur) { unsigned pos = (unsigned)__popcll(bal & ((1ull << lane) - 1ull)); for (int w = 0; w < F.wave; ++w) pos += Wc[w]; Lst[pos] = (unsigned short)F.tid; }
        const int nsel = __builtin_amdgcn_readfirstlane((int)(Wc[0] + Wc[1] + Wc[2] + Wc[3]));
        __syncthreads();
        const char* Kb = KS + (size_t)bh * SEQ * HD * 2; const char* Vb = VS + (size_t)bh * SEQ * HD * 2;
        const int npair = (nsel + 1) >> 1;
        {   const int j0 = __builtin_amdgcn_readfirstlane((int)Lst[0]); ring_dma(RL, Kb + (size_t)j0 * 16384, Vb + (size_t)j0 * 16384, F.lds, F.wave);
            if (nsel > 1) { const int j1 = __builtin_amdgcn_readfirstlane((int)Lst[1]); ring_dma(RL, Kb + (size_t)j1 * 16384, Vb + (size_t)j1 * 16384, F.lds + SLOT, F.wave); } }
        for (int p = 0; p < npair; ++p) {
            asm volatile("s_waitcnt vmcnt(0)" ::: "memory"); RING_BARRIER();
            if (p + 1 < npair && !(DUMMY && MK_EXP == 2)) { const int sl = ((p + 1) & 1) * 2;
                const int j0 = __builtin_amdgcn_readfirstlane((int)Lst[2 * p + 2]); ring_dma(RL, Kb + (size_t)j0 * 16384, Vb + (size_t)j0 * 16384, F.lds + sl * SLOT, F.wave);
                if (2 * p + 3 < nsel) { const int j1 = __builtin_amdgcn_readfirstlane((int)Lst[2 * p + 3]); ring_dma(RL, Kb + (size_t)j1 * 16384, Vb + (size_t)j1 * 16384, F.lds + (sl + 1) * SLOT, F.wave); } }
#pragma unroll 1
            for (int h = 0; h < 2; ++h) { const int si = 2 * p + h; if (si >= nsel) break;
                const int jc = __builtin_amdgcn_readfirstlane((int)Lst[si]);
                LAS unsigned char* sb = F.lds + (((p & 1) * 2) + h) * SLOT;
                unsigned byte = (unsigned)__builtin_amdgcn_readfirstlane((int)((unsigned)(Ml[jc] >> (8 * F.wave)) & 0xffu));
                if (DUMMY && MK_EXP == 1) byte = 0u;
                const unsigned a0 = byte & 0xfu, a1 = byte >> 4;
                if (byte == 0u) continue;
                const bool selA = ((a0 >> (c >> 2)) & 1u) != 0u, selB = ((a1 >> (c >> 2)) & 1u) != 0u;
                const float NINF = -__builtin_inff();
                const int kb = jc * 64; const bool diag = (jc == cur); f32x4 s0[4], s1[4];
                const float bA = selA ? 0.f : NINF, bB = selB ? 0.f : NINF;
                if (a0 != 0u) {
                    qk_tile<1, true>(s0, s1, g0, g0, sb + klane);
                    if (diag) mask_scores(s0, tokA, 0x40000000u, kb, kq);
                    online_sm<true>(s0, g0, bA);
                    pv_tile<1>(g0, g0, s0, s0, lds_addr(sb + KTB) + vlane);
                }
                if (a1 != 0u) {
                    qk_tile<1, true>(s0, s1, g1, g1, sb + klane);
                    if (diag) mask_scores(s0, tokA + 4, 0x40000000u, kb, kq);
                    online_sm<true>(s0, g1, bB);
                    pv_tile<1>(g1, g1, s0, s0, lds_addr(sb + KTB) + vlane);
                }
            }
        }
        __syncthreads();
        {
            const int l2 = lane_id_fresh(), c2 = l2 & 15, kq2 = l2 >> 4, tok2 = t0 + 8 * F.wave + (c2 >> 2), head2 = kvh * GQ + (c2 & 3);
            const size_t qo2 = ((size_t)(b * NH + head2) * SEQ + tok2) * HD;
            const float i0 = gs_inv(g0), i1 = gs_inv(g1);
            const float ga = gates[(size_t)(b * SEQ + tok2) * 48 + head2 * 3 + 1], gb = gates[(size_t)(b * SEQ + tok2 + 4) * 48 + head2 * 3 + 1];
            bf16* dstb = DUMMY ? (bf16*)(F.ws + SC_KV) + (qo2 & (size_t)(16 * MiB - 1)) : OW + qo2;
            gs_store<true>(g0, i0 * ga, dstb + 4 * kq2, OW + qo2 + 4 * kq2, OC + qo2 + 4 * kq2);
            gs_store<true>(g1, i1 * gb, dstb + 4 * HD + 4 * kq2, OW + qo2 + 4 * HD + 4 * kq2, OC + qo2 + 4 * HD + 4 * kq2); }
    }
}

__device__ __forceinline__ void moe_router_phase(Frame& F, int layer, const float* ssq) {
    DenseP S; S.init(F.ws + WS_HB, DM * 2, F.ws + WM_WR + (size_t)layer * 256 * DM * 2, DM, DM, T, 256, F.G, (int)blockIdx.x);
    EpiRouter E{ssq, FIN(I_RBG) + layer * NGRP, FIN(I_RBE) + layer * NEXP, (unsigned*)(F.ws + CT_CNT) + layer * 32 * 64, (int*)(F.ws + SM_LTOK), (float*)(F.ws + SM_LW), (float*)(F.ws + SM_LRS), F.LW};
    pg8::gemm_phase<EpiRouter, DenseP>(F.lds + RING_OFF, S, E, F.tid);
}
__device__ __forceinline__ int moe_setup(Frame& F, int layer) {
    const unsigned* gcnt = (const unsigned*)(F.ws + CT_CNT) + layer * 32 * 64;
    __syncthreads();
    if (F.tid < 32) F.LW[LW_CNT + F.tid] = __hip_atomic_load(gcnt + 64 * F.tid, RLX_AGENT);
    __syncthreads();
    if (F.tid == 0) { unsigned a = 0; for (int e = 0; e < 32; ++e) { F.LW[LW_BLKPRE + e] = a; a += (F.LW[LW_CNT + e] + 255u) >> 8; } F.LW[LW_BLKPRE + 32] = a; }
    __syncthreads();
    return __builtin_amdgcn_readfirstlane((int)F.LW[LW_BLKPRE + 32]);
}
__device__ __forceinline__ void moe_up_phase(Frame& F, int layer) {
    const int nblk = moe_setup(F, layer);
    MoeP S; S.A = (const char*)(F.ws + WS_HB); S.B = (const char*)(F.ws + WS_WGU); S.nt = DM / 64; S.ldb = DM; S.NP = 4; S.G = F.G; S.c = F.vcu; S.total = nblk * 4;
    S.blkpre = F.LW + LW_BLKPRE; S.cnt = F.LW + LW_CNT; S.ltok = (const int*)(F.ws + SM_LTOK); S.gather = true;
    EpiM2 E{(const float*)(F.ws + SM_LRS), (bf16*)(F.ws + SC_HID)};
    pg8::gemm_phase<EpiM2, MoeP>(F.lds + RING_OFF, S, E, F.tid);
}
__device__ __forceinline__ void moe_down_phase(Frame& F, int layer) {
    const int nblk = moe_setup(F, layer);
    MoeP S; S.A = (const char*)(F.ws + SC_HID); S.B = (const char*)(F.ws + WS_WD); S.nt = DEXP / 64; S.ldb = DEXP; S.NP = 8; S.G = F.G; S.c = F.vcu; S.total = nblk * 8;
    S.blkpre = F.LW + LW_BLKPRE; S.cnt = F.LW + LW_CNT; S.ltok = (const int*)(F.ws + SM_LTOK); S.gather = false;
    EpiM3 E{(const int*)(F.ws + SM_LTOK), (const float*)(F.ws + SM_LW), (bf16*)(F.ws + SC_Y)};
    pg8::gemm_phase<EpiM3, MoeP>(F.lds + RING_OFF, S, E, F.tid);
}

#ifndef MK_PH_LO
#define MK_PH_LO 0
#endif
#ifndef MK_PH_HI
#define MK_PH_HI 19
#endif
__global__ void __launch_bounds__(NTHR, 2) mega_fwd(Args args) {
    extern __shared__ __attribute__((aligned(16))) unsigned char lds_raw[];
    Frame F;
    F.lds = (LAS unsigned char*)lds_raw; F.LW = (volatile LAS unsigned*)(F.lds + LCTL_OFF);
    F.tid = threadIdx.x; F.lane = F.tid & 63; F.wave = __builtin_amdgcn_readfirstlane(F.tid >> 6);
#define PHASE_BEGIN() do { F.lane = lane_id_fresh(); F.tid = F.wave * 64 + F.lane; } while (0)
    F.G = gridDim.x; { const int bx = blockIdx.x; F.vcu = (F.G % 8 == 0) ? (bx % 8) * (F.G / 8) + bx / 8 : bx; }
    F.ws = args.ws; F.out = args.out;
    F.ap = &args;
    for (int u = F.tid; u < 256; u += NTHR) F.LW[u] = 0u;
    __syncthreads();
    XcdBarrier bar = xcd_barrier_post((unsigned*)(F.ws + CT_BAR) + args.li * XCD_BAR_WORDS, F.LW + LW_BAR, F.tid);
    const int lo = args.ph_lo, hi = args.ph_hi; const int BX = (int)blockIdx.x;
#ifndef MK_MASK
#define MK_MASK 0x7ffff
#endif
#define IN(k) ((((MK_MASK) >> (k)) & 1) && lo <= (k) && (k) < hi)
#ifndef MK_DUP
#define MK_DUP 0
#endif
#define DUP(k) ((((MK_DUP) >> (k)) & 1) != 0)
#define DUPBAR() do { PHASE_BEGIN(); xcd_barrier(bar, F.tid); } while (0)
#define SEAM(k) do { PHASE_BEGIN(); if (IN(k) && (k) + 1 < hi && (((MK_MASK) >> ((k) + 1)) != 0)) xcd_barrier(bar, F.tid); } while (0)
    float* ssq0 = (float*)(F.ws + SM_SSQ0); float* ssq1 = (float*)(F.ws + WM_SSQP); float* ssq2 = (float*)(F.ws + SM_SSQ2); float* ssq3 = (float*)(F.ws + WM_SSQP);
    bf16* HB = (bf16*)(F.ws + WS_HB);

    if (IN(0)) { p0_prologue(F); if (DUP(0)) { DUPBAR(); p0_prologue(F); } } SEAM(0);
    if (IN(1)) {
        DenseP S; S.init(HB, DM * 2, F.ws + WM_AIN, DM, DM, T, 2 * GMW, F.G, BX);
        EpiA1 E{ssq0, (bf16*)(F.ws + SC_U), (bf16*)(F.ws + SC_V), (float*)(F.ws + SC_LNSP)};
        pg8::gemm_phase<EpiA1, DenseP>(F.lds + RING_OFF, S, E, F.tid);
        if (DUP(1)) { DUPBAR(); pg8::gemm_phase<EpiA1, DenseP>(F.lds + RING_OFF, S, E, F.tid); }
    } SEAM(1);
    if (IN(2)) { gating_phase(F); } SEAM(2);
    if (IN(3)) {
        DenseP S; S.init(F.ws + SC_U, GMW * 2, F.ws + WM_AOUT, GMW, GMW, T, DM, F.G, BX);
        EpiRes E{HB, ssq1};
        pg8::gemm_phase<EpiRes, DenseP>(F.lds + RING_OFF, S, E, F.tid);
    } SEAM(3);
    if (IN(4)) { moe_router_phase(F, 0, ssq1); } SEAM(4);
    if (IN(5)) { moe_up_phase(F, 0); if (DUP(5)) { DUPBAR(); moe_up_phase(F, 0); } } SEAM(5);
    if (IN(6)) { moe_down_phase(F, 0); if (DUP(6)) { DUPBAR(); moe_down_phase(F, 0); } } SEAM(6);
    if (IN(7)) { combine_phase<false, ((MK_MASK >> 6) & 1) != 0>(F, ssq2); moe_weight_items(F, 1, F.vcu * NWAVES + F.wave, F.G * NWAVES); } SEAM(7);
    if (IN(8)) {
        DenseP S; S.init(HB, DM * 2, F.ws + WM_BIN, DM, DM, T, NSA_INP, F.G, BX);
        EpiN1 E{ssq2, (bf16*)(F.ws + SC_Q), (bf16*)(F.ws + SC_KV), (float*)(F.ws + SM_GATES)};
        pg8::gemm_phase<EpiN1, DenseP>(F.lds + RING_OFF, S, E, F.tid);
        if (DUP(8)) { DUPBAR(); pg8::gemm_phase<EpiN1, DenseP>(F.lds + RING_OFF, S, E, F.tid); }
    } SEAM(8);
    if (IN(9)) {
        CmpP S; S.init(F.ws + SC_KV, 4096, F.ws + WM_C1, 2048, 2048, 8192, 256, F.G, BX);
        EpiF32 E{(float*)(F.ws + SC_LOHI)};
        pg8::gemm_phase<EpiF32, CmpP>(F.lds + RING_OFF, S, E, F.tid);
    } SEAM(9);
    if (IN(10)) { cmp_finalize_phase(F); if (DUP(10)) { DUPBAR(); cmp_finalize_phase(F); } } SEAM(10);
    if (IN(11)) { window_phase(F); if (DUP(11)) { DUPBAR(); window_phase(F); } } SEAM(11);
    if (IN(12)) { cmp_phase(F); if (DUP(12)) { DUPBAR(); cmp_phase(F); } } SEAM(12);
    if (IN(13)) { if (DUP(13)) { sel_phase<true>(F); DUPBAR(); } sel_phase<false>(F); } SEAM(13);
    if (IN(14)) {
        HeadMajorP S; S.init(F.ws + SC_OW, 0, F.ws + WM_BOUT, DM, DM, T, DM, F.G, BX);
        EpiRes E{HB, ssq3};
        pg8::gemm_phase<EpiRes, HeadMajorP>(F.lds + RING_OFF, S, E, F.tid);
    } SEAM(14);
    if (IN(15)) { moe_router_phase(F, 1, ssq3); } SEAM(15);
    if (IN(16)) { moe_up_phase(F, 1); } SEAM(16);
    if (IN(17)) { moe_down_phase(F, 1); } SEAM(17);
    if (IN(18)) { combine_phase<true, ((MK_MASK >> 17) & 1) != 0>(F, nullptr); }
#undef IN
#undef SEAM
}

extern "C" void kernel_launch(void* const* d_in, const int* in_sizes, int n_in, void* d_out, int out_size, void* d_ws, size_t ws_size, hipStream_t stream) {
    static int grid = 0;
    if (grid == 0) {
        if (n_in != 25 || in_sizes[0] != T * DM || out_size != T * DM || ws_size < WS_END) { fprintf(stderr, "kernel_launch: unexpected shapes / workspace (n_in %d, ws %zu < %zu)\n", n_in, ws_size, (size_t)WS_END); grid = -1; return; }
        int dev = 0, cus = 0;
        if (hipGetDevice(&dev) != hipSuccess || hipDeviceGetAttribute(&cus, hipDeviceAttributeMultiprocessorCount, dev) != hipSuccess) { grid = -1; return; }
        if (hipFuncSetAttribute((const void*)mega_fwd, hipFuncAttributeMaxDynamicSharedMemorySize, LDS_BYTES) != hipSuccess) { fprintf(stderr, "kernel_launch: hipFuncSetAttribute failed\n"); grid = -1; return; }
        int per_cu = 0;
        if (hipOccupancyMaxActiveBlocksPerMultiprocessor(&per_cu, (const void*)mega_fwd, NTHR, LDS_BYTES) != hipSuccess || per_cu < 1) fprintf(stderr, "kernel_launch: occupancy query reports %d\n", per_cu);
        (void)hipGetLastError();
        grid = cus;
    }
    if (grid < 0) return;
    if (hipMemsetAsync((char*)d_ws + WS_CTL, 0, CTL_ZERO_BYTES, stream) != hipSuccess) return;
#ifdef MK_DBG_NANY
    (void)hipMemsetAsync((char*)d_ws + SC_Y, 0xFF, 256 * MiB, stream);
#endif
    Args a{};
    for (int i = 0; i < 25; ++i) a.in[i] = (const float*)d_in[i];
    a.out = (float*)d_out; a.ws = (unsigned char*)d_ws;
#ifdef MK_CUTS
    const int cuts[] = MK_CUTS;
    const int nl = (int)(sizeof(cuts) / sizeof(int)) - 1;
#else
    const int cuts[] = {MK_PH_LO, MK_PH_HI}; const int nl = 1;
#endif
    for (int li = 0; li < nl; ++li) { a.ph_lo = cuts[li]; a.ph_hi = cuts[li + 1]; a.li = li; a.pad = 0;
        hipLaunchKernelGGL(mega_fwd, dim3(grid), dim3(NTHR), LDS_BYTES, stream, a); }
}
```
